# Optimizing an MI355X kernel written in HIP

```python
import math
import jax, jax.numpy as jnp
from jax import lax
import numpy as np

D_MODEL = 1024
BATCH = 8
SEQ = 4096
DEPTH = 1

GDN_HEADS = 8
GDN_HEAD_DIM = 64
GDN_WIDTH = GDN_HEADS * GDN_HEAD_DIM
GDN_CONV = 4
GDN_CHUNK = 64
RWKV_HEADS = 8
RWKV_HEAD_DIM = 64
RWKV_WIDTH = RWKV_HEADS * RWKV_HEAD_DIM
DECAY_LORA = 64
ICLR_LORA = 64
GATE_LORA = 160
RWKV_COLS = 3 * RWKV_WIDTH + DECAY_LORA + ICLR_LORA + GATE_LORA
IN_SIZES = (3 * GDN_WIDTH, GDN_WIDTH, GDN_HEADS, GDN_HEADS, RWKV_COLS, D_MODEL, D_MODEL)
D_IN = 3 * GDN_WIDTH + GDN_WIDTH + 2 * GDN_HEADS + RWKV_COLS + 2 * D_MODEL
D_FF = 2816
FFN_CONV = 3
NORM_EPS = 1e-6
LNX_EPS = 64e-5

kernel_name = "hybrid_gdn_rwkv7_convglu_adaln"


def rms_norm(x, w, eps=NORM_EPS):
    xf = x.astype(jnp.float32)
    y = xf * lax.rsqrt(jnp.mean(xf * xf, axis=-1, keepdims=True) + eps)
    return (y * w.astype(jnp.float32)).astype(x.dtype)


def l2_normalize(x, eps=1e-6):
    xf = x.astype(jnp.float32)
    return xf * lax.rsqrt(jnp.sum(xf * xf, axis=-1, keepdims=True) + eps)


def split_cols(p, sizes):
    out, start = [], 0
    for s in sizes:
        out.append(p[..., start:start + s])
        start += s
    return out


def token_shift(p):
    return jnp.pad(p, ((0, 0), (1, 0), (0, 0)))[:, :-1]


def causal_depthwise_conv(x, w):
    k = w.shape[0]
    return lax.conv_general_dilated(
        x, w[:, None, :].astype(x.dtype), window_strides=(1,), padding=((k - 1, 0),),
        dimension_numbers=('NWC', 'WIO', 'NWC'), feature_group_count=x.shape[-1])


def chunk_gated_delta_rule(q, k, v, g, beta):
    B, T, H, dk = q.shape
    dv = v.shape[-1]
    C = GDN_CHUNK
    n = T // C
    to_chunks = lambda t: t.reshape(B, n, C, H, -1).transpose(0, 3, 1, 2, 4)
    q, k, v = to_chunks(q), to_chunks(k), to_chunks(v)
    g = g.reshape(B, n, C, H).transpose(0, 3, 1, 2)
    beta = beta.reshape(B, n, C, H).transpose(0, 3, 1, 2)
    g_cum = jnp.cumsum(g, axis=-1)
    causal = jnp.tril(jnp.ones((C, C), dtype=bool))
    strict = jnp.tril(jnp.ones((C, C), dtype=bool), -1)
    diff = g_cum[..., :, None] - g_cum[..., None, :]
    decay = jnp.where(causal, jnp.exp(jnp.where(causal, diff, 0.0)), 0.0)
    k_beta = k * beta[..., None]
    v_beta = v * beta[..., None]
    lower = jnp.where(strict, jnp.einsum('bhncd,bhnsd->bhncs', k_beta, k) * decay, 0.0)
    eye = jnp.eye(C, dtype=q.dtype)
    t_mat = lax.linalg.triangular_solve(lower + eye, jnp.broadcast_to(eye, lower.shape),
                                        left_side=True, lower=True, unit_diagonal=True)
    u = jnp.matmul(t_mat, v_beta)
    w = jnp.matmul(t_mat, k_beta * jnp.exp(g_cum)[..., None])
    attn = jnp.where(causal, jnp.einsum('bhncd,bhnsd->bhncs', q, k) * decay, 0.0)

    def step(S, inp):
        q_i, k_i, u_i, w_i, a_i, gc_i = inp
        v_new = u_i - jnp.matmul(w_i, S)
        o_i = jnp.matmul(q_i * jnp.exp(gc_i)[..., None], S) + jnp.matmul(a_i, v_new)
        g_last = gc_i[..., -1]
        k_dec = k_i * jnp.exp(g_last[..., None] - gc_i)[..., None]
        S = S * jnp.exp(g_last)[..., None, None] + jnp.einsum('bhcd,bhce->bhde', k_dec, v_new)
        return S, o_i

    mv = lambda t: jnp.moveaxis(t, 2, 0)
    S0 = jnp.zeros((B, H, dk, dv), dtype=q.dtype)
    _, o = lax.scan(step, S0, (mv(q), mv(k), mv(u), mv(w), mv(attn), mv(g_cum)))
    return o.transpose(1, 0, 3, 2, 4).reshape(B, T, H, dv)


def gated_deltanet(qkv, z, b_logit, a_logit, conv_w, a_log, dt_bias, onorm_w):
    B, T, _ = qkv.shape
    qkv = jax.nn.silu(causal_depthwise_conv(qkv, conv_w)).astype(jnp.float32)
    q, k, v = jnp.split(qkv, 3, axis=-1)
    heads = lambda t: t.reshape(B, T, GDN_HEADS, GDN_HEAD_DIM)
    q = l2_normalize(heads(q)) * (GDN_HEAD_DIM ** -0.5)
    k = l2_normalize(heads(k))
    v = heads(v)
    beta = jax.nn.sigmoid(b_logit.astype(jnp.float32))
    g = -jnp.exp(a_log.astype(jnp.float32)) * jax.nn.softplus(
        a_logit.astype(jnp.float32) + dt_bias.astype(jnp.float32))
    o = chunk_gated_delta_rule(q, k, v, g, beta)
    o = rms_norm(o, onorm_w) * jax.nn.silu(heads(z).astype(jnp.float32))
    return o.reshape(B, T, GDN_WIDTH)


def rwkv7_scan(r, decay, k, v, a, b):
    B, T, H, N = r.shape

    def step(S, inp):
        r_t, w_t, k_t, v_t, a_t, b_t = inp
        sa = jnp.einsum('bhvk,bhk->bhv', S, a_t)
        S = S * w_t[:, :, None, :] + sa[..., None] * b_t[:, :, None, :] + v_t[..., None] * k_t[:, :, None, :]
        return S, jnp.einsum('bhvk,bhk->bhv', S, r_t)

    tm = lambda t: jnp.moveaxis(t, 1, 0)
    S0 = jnp.zeros((B, H, N, N), dtype=jnp.float32)
    _, y = lax.scan(step, S0, (tm(r), tm(decay), tm(k), tm(v), tm(a), tm(b)))
    return jnp.moveaxis(y, 0, 1)


def rwkv7_time_mix(pb, mu, w0, w2, a0, a2, g2, k_k, k_a, r_k, lnx_w, lnx_b):
    f32 = lambda t: t.astype(jnp.float32)
    B, T, _ = pb.shape
    pb = f32(pb)
    pb = pb + (token_shift(pb) - pb) * f32(mu)
    r, k, v, w_lo, a_lo, g_lo = split_cols(
        pb, (RWKV_WIDTH, RWKV_WIDTH, RWKV_WIDTH, DECAY_LORA, ICLR_LORA, GATE_LORA))
    w = -jax.nn.softplus(-(f32(w0) + jnp.tanh(w_lo) @ f32(w2))) - 0.5
    decay = jnp.exp(-jnp.exp(w))
    a = jax.nn.sigmoid(f32(a0) + a_lo @ f32(a2))
    g = jax.nn.sigmoid(g_lo) @ f32(g2)
    heads = lambda t: t.reshape(B, T, RWKV_HEADS, RWKV_HEAD_DIM)
    kk = l2_normalize(heads(k * f32(k_k)))
    k = k * (1.0 + (a - 1.0) * f32(k_a))
    r, k, v, a, decay = heads(r), heads(k), heads(v), heads(a), heads(decay)
    y = rwkv7_scan(r, decay, k, v, -kk, kk * a)
    mean = jnp.mean(y, axis=-1, keepdims=True)
    var = jnp.mean(jnp.square(y - mean), axis=-1, keepdims=True)
    y = ((y - mean) * lax.rsqrt(var + LNX_EPS)).reshape(B, T, RWKV_WIDTH) * f32(lnx_w) + f32(lnx_b)
    bonus = jnp.sum(r * k * f32(r_k), axis=-1, keepdims=True) * v
    return (y + bonus.reshape(B, T, RWKV_WIDTH)) * g


def conv_glu(h, w_in, conv_w, w_out):
    gate, up = jnp.split(h @ w_in, 2, axis=-1)
    gate = causal_depthwise_conv(gate, conv_w)
    return (jax.nn.silu(gate) * up) @ w_out


def setup_inputs(seed: int = 0) -> dict:
    key = jax.random.key(seed)
    ks = iter(jax.random.split(key, 40))
    nrm = lambda shape, scale: jax.random.normal(next(ks), shape, jnp.float32) * scale
    uni = lambda shape, lo, hi: jax.random.uniform(next(ks), shape, jnp.float32, minval=lo, maxval=hi)
    L = DEPTH
    x = nrm((BATCH, SEQ, D_MODEL), 1.0)
    c = nrm((BATCH, D_MODEL), 1.0)
    w_ada = nrm((L, D_MODEL, 6 * D_MODEL), D_MODEL ** -0.5)
    b_ada = nrm((L, 6 * D_MODEL), 0.02)
    norm1_w = 1.0 + nrm((L, D_MODEL), 0.02)
    w_in = nrm((L, D_MODEL, D_IN), D_MODEL ** -0.5)
    conv_gdn = nrm((L, GDN_CONV, 3 * GDN_WIDTH), GDN_CONV ** -0.5)
    a_log = jnp.log(uni((L, GDN_HEADS), 1.0, 16.0))
    dt = jnp.exp(uni((L, GDN_HEADS), math.log(1e-3), math.log(1e-1)))
    dt_bias = dt + jnp.log(-jnp.expm1(-dt))
    onorm_gdn = 1.0 + nrm((L, GDN_HEAD_DIM), 0.02)
    w_branch_gdn = nrm((L, GDN_WIDTH, D_MODEL), GDN_WIDTH ** -0.5)
    mu_rwkv = uni((L, RWKV_COLS), 0.0, 1.0)
    w0 = uni((L, RWKV_WIDTH), -6.5, -1.5)
    w2 = nrm((L, DECAY_LORA, RWKV_WIDTH), 0.5 * DECAY_LORA ** -0.5)
    a0 = nrm((L, RWKV_WIDTH), 0.1)
    a2 = nrm((L, ICLR_LORA, RWKV_WIDTH), 0.5 * ICLR_LORA ** -0.5)
    g2 = nrm((L, GATE_LORA, RWKV_WIDTH), GATE_LORA ** -0.5)
    k_k = 0.85 + nrm((L, RWKV_WIDTH), 0.02)
    k_a = 1.0 + nrm((L, RWKV_WIDTH), 0.02)
    r_k = nrm((L, RWKV_HEADS, RWKV_HEAD_DIM), 0.1)
    lnx_w = 1.0 + nrm((L, RWKV_WIDTH), 0.02)
    lnx_b = nrm((L, RWKV_WIDTH), 0.02)
    w_branch_rwkv = nrm((L, RWKV_WIDTH, D_MODEL), RWKV_WIDTH ** -0.5)
    w_out = nrm((L, D_MODEL, D_MODEL), D_MODEL ** -0.5)
    norm2_w = 1.0 + nrm((L, D_MODEL), 0.02)
    w_ffn_in = nrm((L, D_MODEL, 2 * D_FF), D_MODEL ** -0.5)
    conv_ffn = nrm((L, FFN_CONV, D_FF), FFN_CONV ** -0.5)
    w_ffn_out = nrm((L, D_FF, D_MODEL), D_FF ** -0.5)
    norm_f_w = 1.0 + nrm((D_MODEL,), 0.02)
    return {"x": x, "c": c, "w_ada": w_ada, "b_ada": b_ada, "norm1_w": norm1_w, "w_in": w_in,
            "conv_gdn": conv_gdn, "a_log": a_log, "dt_bias": dt_bias, "onorm_gdn": onorm_gdn,
            "w_branch_gdn": w_branch_gdn, "mu_rwkv": mu_rwkv, "w0": w0, "w2": w2, "a0": a0, "a2": a2,
            "g2": g2, "k_k": k_k, "k_a": k_a, "r_k": r_k, "lnx_w": lnx_w, "lnx_b": lnx_b,
            "w_branch_rwkv": w_branch_rwkv, "w_out": w_out, "norm2_w": norm2_w, "w_ffn_in": w_ffn_in,
            "conv_ffn": conv_ffn, "w_ffn_out": w_ffn_out, "norm_f_w": norm_f_w}


def reference(x, c, w_ada, b_ada, norm1_w, w_in, conv_gdn, a_log, dt_bias, onorm_gdn, w_branch_gdn,
              mu_rwkv, w0, w2, a0, a2, g2, k_k, k_a, r_k, lnx_w, lnx_b, w_branch_rwkv, w_out,
              norm2_w, w_ffn_in, conv_ffn, w_ffn_out, norm_f_w):
    cond = jax.nn.silu(c)
    for i in range(DEPTH):
        mod = cond @ w_ada[i] + b_ada[i]
        shift1, scale1, gate1, shift2, scale2, gate2 = jnp.split(mod[:, None, :], 6, axis=-1)
        h = rms_norm(x, norm1_w[i]) * (1.0 + scale1) + shift1
        p = h @ w_in[i]
        qkv_a, z_a, b_a, a_a, p_b, gl_a, gl_b = split_cols(p, IN_SIZES)
        y_a = gated_deltanet(qkv_a, z_a, b_a, a_a, conv_gdn[i], a_log[i], dt_bias[i], onorm_gdn[i])
        y_b = rwkv7_time_mix(p_b, mu_rwkv[i], w0[i], w2[i], a0[i], a2[i], g2[i], k_k[i], k_a[i],
                             r_k[i], lnx_w[i], lnx_b[i])
        y_a = y_a.astype(x.dtype) @ w_branch_gdn[i]
        y_b = y_b.astype(x.dtype) @ w_branch_rwkv[i]
        merged = jax.nn.sigmoid(gl_a) * y_a + jax.nn.sigmoid(gl_b) * y_b
        x = x + gate1 * (merged @ w_out[i])
        h = rms_norm(x, norm2_w[i]) * (1.0 + scale2) + shift2
        x = x + gate2 * conv_glu(h, w_ffn_in[i], conv_ffn[i], w_ffn_out[i])
    return rms_norm(x, norm_f_w)
```

```cpp
#include <hip/hip_runtime.h>
#include <hip/hip_cooperative_groups.h>
#include <cstdio>
namespace cg = cooperative_groups;

#define LAS __attribute__((address_space(3)))
typedef unsigned short bf16_t;
typedef short bf16x8 __attribute__((ext_vector_type(8)));
typedef float f32x4 __attribute__((ext_vector_type(4)));
typedef float f32x2 __attribute__((ext_vector_type(2)));
typedef unsigned u32x4 __attribute__((ext_vector_type(4)));
typedef unsigned u32x2 __attribute__((ext_vector_type(2)));

constexpr int NTOK = 32768, T = 4096, D = 1024;
constexpr int LDP = 6144;
constexpr int PC_Z = 1536, PC_RB = 2048, PC_LO = 3584, PC_GL = 4096;
constexpr int LDGU = 5632, DFF = 2816, LDLO = 1536, LDALO = 384;
constexpr int XCD_BAR_WORDS_C = 3456;
constexpr int LDS_STAGE = 131072;
constexpr int LDS_BYTES = LDS_STAGE + 16;

constexpr size_t WS_WTIN = 0;
constexpr size_t WS_WTBR = WS_WTIN + (size_t)6144 * 1024 * 2;
constexpr size_t WS_WTOUT = WS_WTBR + (size_t)2048 * 512 * 2;
constexpr size_t WS_WTF1 = WS_WTOUT + (size_t)1024 * 1024 * 2;
constexpr size_t WS_WTF2 = WS_WTF1 + (size_t)5632 * 1024 * 2;
constexpr size_t WS_WTLO = WS_WTF2 + (size_t)1024 * 2816 * 2;
constexpr size_t WS_MOD = WS_WTLO + (size_t)1536 * 384 * 2;
constexpr size_t WS_BA = WS_MOD + (size_t)8 * 6144 * 4;
constexpr size_t WS_H = WS_BA + (size_t)NTOK * 16 * 4;
constexpr size_t WS_P = WS_H + (size_t)NTOK * 1024 * 2;
constexpr size_t WS_HALO = WS_P + (size_t)NTOK * LDP * 2;
constexpr size_t WS_BAR = WS_HALO + (size_t)256 * 3 * 3072 * 2;
constexpr size_t WS_PEND = WS_BAR + (size_t)XCD_BAR_WORDS_C * 4;
constexpr size_t WS_BND = WS_PEND + (size_t)(NTOK / 32) * 512 * 4;
constexpr size_t WS_END = WS_BND + (size_t)256 * 4 * 5632 * 2;

struct Params {
    const float *x, *c, *w_ada, *b_ada, *norm1_w, *w_in, *conv_gdn, *a_log, *dt_bias, *onorm_gdn, *w_branch_gdn, *mu_rwkv, *w0, *w2, *a0, *a2, *g2, *k_k, *k_a, *r_k,
        *lnx_w, *lnx_b, *w_branch_rwkv, *w_out, *norm2_w, *w_ffn_in, *conv_ffn, *w_ffn_out, *norm_f_w;
    float* out;
    unsigned char* ws;
};

typedef __bf16 bf16v2_t __attribute__((ext_vector_type(2)));
__device__ __forceinline__ unsigned pk2(float lo, float hi) { const bf16v2_t t = __builtin_convertvector((f32x2){lo, hi}, bf16v2_t); return __builtin_bit_cast(unsigned, t); }
__device__ __forceinline__ float bf2f(bf16_t b) { return __uint_as_float(((unsigned)b) << 16); }
__device__ __forceinline__ bf16_t f2bf(float f) { return (bf16_t)(pk2(f, 0.f) & 0xffffu); }
__device__ __forceinline__ float lo_bf(unsigned u) { return __uint_as_float(u << 16); }
__device__ __forceinline__ float hi_bf(unsigned u) { return __uint_as_float(u & 0xffff0000u); }
__device__ __forceinline__ float sigm(float x) { return __builtin_amdgcn_rcpf(1.f + __expf(-x)); }
__device__ __forceinline__ float silu_(float x) { return x * __builtin_amdgcn_rcpf(1.f + __expf(-x)); }
__device__ __forceinline__ float softplus_(float x) { return x > 20.f ? x : log1pf(expf(x)); }
__device__ __forceinline__ float wave_sum(float v) {
#pragma unroll
    for (int o = 1; o < 64; o <<= 1) v += __shfl_xor(v, o);
    return v;
}
__device__ __forceinline__ float dpp_f(float x, const int ctrl_sel) {
    int xi = __builtin_bit_cast(int, x), r;
    if (ctrl_sel == 0) r = __builtin_amdgcn_update_dpp(0, xi, 0xB1, 0xF, 0xF, true);
    else if (ctrl_sel == 1) r = __builtin_amdgcn_update_dpp(0, xi, 0x4E, 0xF, 0xF, true);
    else r = __builtin_amdgcn_update_dpp(0, xi, 0x141, 0xF, 0xF, true);
    return __builtin_bit_cast(float, r);
}
__device__ __forceinline__ float dpp_rm(float x) { int xi = __builtin_bit_cast(int, x); return __builtin_bit_cast(float, __builtin_amdgcn_update_dpp(0, xi, 0x140, 0xF, 0xF, true)); }
__device__ __forceinline__ float wsum(float x) {
    x += dpp_f(x, 0); x += dpp_f(x, 1); x += dpp_f(x, 2); x += dpp_rm(x);
    const int xi = __builtin_bit_cast(int, x);
    const float a = __builtin_bit_cast(float, __builtin_amdgcn_readlane(xi, 0)), b = __builtin_bit_cast(float, __builtin_amdgcn_readlane(xi, 16));
    const float c = __builtin_bit_cast(float, __builtin_amdgcn_readlane(xi, 32)), d = __builtin_bit_cast(float, __builtin_amdgcn_readlane(xi, 48));
    return (a + b) + (c + d);
}
__device__ __forceinline__ float red8(float x) { x += dpp_f(x, 0); x += dpp_f(x, 1); x += dpp_f(x, 2); return x; }

__device__ __forceinline__ void unpack8(const u32x4 u, float (&v)[8]) {
    v[0] = lo_bf(u.x); v[1] = hi_bf(u.x); v[2] = lo_bf(u.y); v[3] = hi_bf(u.y); v[4] = lo_bf(u.z); v[5] = hi_bf(u.z); v[6] = lo_bf(u.w); v[7] = hi_bf(u.w);
}
__device__ __forceinline__ u32x4 pack8(const float (&v)[8]) { u32x4 o; o.x = pk2(v[0], v[1]); o.y = pk2(v[2], v[3]); o.z = pk2(v[4], v[5]); o.w = pk2(v[6], v[7]); return o; }
__device__ __forceinline__ int opaque_tid(int wv) { int t; asm volatile("v_mbcnt_lo_u32_b32 %0, -1, 0\n\tv_mbcnt_hi_u32_b32 %0, -1, %0" : "=v"(t)); return wv * 64 + t; }
__device__ __forceinline__ int opaque_bid() { int t = blockIdx.x; asm volatile("" : "+s"(t)); return t; }

#define XB_TMO      128
#define XB_XCNT(j)  (256  + 64 * (j))
#define XB_XSUB(j)  (1280 + 64 * (j))
#define XB_XGEN(j)  (2304 + 64 * (j))
#define XB_TOP      3328
#define XB_TOPGEN   3392
#define XCD_BAR_WORDS 3456
#define XB_SPIN_CAP (1u << 18)
__device__ __forceinline__ unsigned xb_ld(unsigned* p)              { return __hip_atomic_load(p, __ATOMIC_RELAXED, __HIP_MEMORY_SCOPE_AGENT); }
__device__ __forceinline__ unsigned xb_add(unsigned* p, unsigned v) { return __hip_atomic_fetch_add(p, v, __ATOMIC_RELAXED, __HIP_MEMORY_SCOPE_AGENT); }
__device__ __forceinline__ unsigned xb_xcc_id() { return (unsigned)__builtin_amdgcn_s_getreg((3 << 11) | 20) & 0xFu; }
#define XB_SPIN(cond, bar) do { unsigned _sp = 0; while (cond) { __builtin_amdgcn_s_sleep(1); \
    if ((++_sp & 255u) == 0u) { if (xb_ld(&(bar)[XB_TMO])) break; if (_sp > XB_SPIN_CAP) { atomicAdd(&(bar)[XB_TMO], 1u); break; } } } } while (0)
struct XcdBarrier { unsigned* bar; unsigned x; volatile LAS unsigned* st; };
__device__ __forceinline__ void xcd_barrier_complete(unsigned* bar, unsigned x, unsigned& nloc, unsigned& nx) {
    const unsigned G = gridDim.x * gridDim.y * gridDim.z;
    unsigned sum, cnt, mine, sp = 0u;
    for (;;) {
        sum = 0u; cnt = 0u; mine = 0u;
#pragma unroll
        for (unsigned j = 0; j < 16; ++j) { const unsigned c = xb_ld(&bar[XB_XCNT(j)]); sum += c; cnt += (c > 0u) ? 1u : 0u; mine = (j == x) ? c : mine; }
        if (sum == G) break;
        __builtin_amdgcn_s_sleep(1);
        if ((++sp & 255u) == 0u) { if (xb_ld(&bar[XB_TMO])) break; if (sp > XB_SPIN_CAP) { atomicAdd(&bar[XB_TMO], 1u); break; } }
    }
    nloc = mine > 0u ? mine : 1u; nx = cnt > 0u ? cnt : 1u;
}
__device__ __forceinline__ void xcd_barrier(int wv, const XcdBarrier& b) {
    asm volatile("s_waitcnt vmcnt(0)" ::: "memory");
    __syncthreads();
    if (opaque_tid(wv) == 0) {
        unsigned* bar = b.bar;
        __builtin_amdgcn_s_waitcnt(0);
        unsigned nloc = b.st[0], nx = b.st[1];
        if (nloc == 0u) { xcd_barrier_complete(bar, b.x, nloc, nx); b.st[0] = nloc; b.st[1] = nx; }
        const unsigned old = xb_add(&bar[XB_XSUB(b.x)], 1u);
        const unsigned gen = old / nloc;
        if (old + 1u == (gen + 1u) * nloc) {
            __builtin_amdgcn_fence(__ATOMIC_RELEASE, "agent");
            asm volatile("s_waitcnt vmcnt(0)" ::: "memory");
            const unsigned og = xb_add(&bar[XB_TOP], 1u);
            const unsigned tg = og / nx;
            if (og + 1u == (tg + 1u) * nx) xb_add(&bar[XB_TOPGEN], 1u);
            else XB_SPIN(xb_ld(&bar[XB_TOPGEN]) == tg, bar);
            __builtin_amdgcn_fence(__ATOMIC_ACQUIRE, "agent");
            xb_add(&bar[XB_XGEN(b.x)], 1u);
            asm volatile("s_waitcnt vmcnt(0)" ::: "memory");
        } else {
            XB_SPIN(xb_ld(&bar[XB_XGEN(b.x)]) == gen, bar);
            __builtin_amdgcn_fence(__ATOMIC_ACQUIRE, "agent");
            asm volatile("s_waitcnt vmcnt(0)" ::: "memory");
        }
    }
    __syncthreads();
}
namespace pg8 {
constexpr int BM = 256, BK = 64, HALF = 128, HTB = HALF * BK * 2, NXCD = 8, WGM = 8;
__device__ __forceinline__ int lds_byte(int r, int c) { const int st = (r >> 4) * 2 + (c >> 5), rr = r & 15, cc = c & 31, ob = rr * 64 + cc * 2; return st * 1024 + (ob ^ (((ob >> 9) & 1) << 5)); }
__device__ __forceinline__ void stage_rc(int b, int& R, int& C) { const int st = b / 1024, sb = b % 1024, swz = sb ^ (((sb >> 9) & 1) << 5); R = (st >> 1) * 16 + swz / 64; C = (st & 1) * 32 + (swz % 64) / 2; }
__device__ __forceinline__ int perm32(int rho) { const int n = rho >> 4, i = rho & 15; return 8 * (i >> 2) + 4 * n + (i & 3); }
struct Unit { int pm, pn; };
struct Gemm { const bf16_t* A; const bf16_t* Bt; int M, N, K, lda, ldb, asplit, aoff2; };
struct StaticOrder {
    int nM, nN, nwg, G, c;
    __device__ void init(int M, int N, int G_, int c_) { nM = M / BM; nN = N / BM; nwg = nM * nN; G = G_; c = c_; }
    __device__ bool next(int i, Unit& u) const {
        const long L = (long)i * G + c; if (L >= nwg) return false;
        int wgid = (int)L; { const int q = nwg / NXCD, r = nwg % NXCD, xcd = wgid % NXCD, off = wgid / NXCD; wgid = (xcd < r ? xcd * (q + 1) : r * (q + 1) + (xcd - r) * q) + off; }
        const int nig = WGM * nN, gid = wgid / nig, fm = gid * WGM, gsz = (nM - fm) < WGM ? (nM - fm) : WGM;
        u.pm = fm + ((wgid % nig) % gsz); u.pn = (wgid % nig) / gsz; return true;
    }
};

struct PairOrder {
    StaticOrder so;
    __device__ bool next(int i, Unit& u) const { Unit t; if (!so.next(i >> 1, t)) return false; u.pm = t.pm; u.pn = t.pn + 4 * (i & 1); return true; }
};
template <class Epi, class Sched>
__device__ __forceinline__ void gemm_phase(int wv, LAS unsigned char* lds, const Gemm g, const Sched& S, const Epi& E) {
    const int tid = opaque_tid(wv), wid = __builtin_amdgcn_readfirstlane(tid >> 6), lane = tid & 63, wr = wid >> 2, wc = wid & 3, fr = lane & 15, fq = lane >> 4;
    const int K = g.K, nt = K / BK;
    unsigned voffA[2], voffB[2];
#pragma unroll
    for (int i = 0; i < 2; ++i) { int R, C; stage_rc(tid * 16 + i * 8192, R, C); const int Rb = Epi::PERM ? ((R & ~31) + perm32(R & 31)) : R;
        const int Ra = Epi::ROWPERM ? (8 * ((R & 15) + 16 * (R >> 6)) + ((R >> 4) & 3)) : R;
        voffA[i] = (unsigned)(Ra * g.lda + C) * 2u; voffB[i] = (unsigned)(Rb * g.ldb + C) * 2u; }
    const size_t kstep = (size_t)(BK * 2);
    const size_t hstepA = Epi::ROWPERM ? (size_t)4 * g.lda * 2 : (size_t)HALF * g.lda * 2, hstepB = (size_t)HALF * g.ldb * 2;
    const size_t tstepA = (size_t)2 * HALF * g.lda * 2, tstepB = 2 * hstepB;
    const unsigned ldsw = (unsigned)wid * 1024u;
    const int aoff = lds_byte(wr * 64 + fr, fq * 8), boff = lds_byte(wc * 32 + fr, fq * 8);
#define PG8_SA(b, h) (((b) * 2 + (h)) * HTB)
#define PG8_SB(b, h) ((4 + (b) * 2 + (h)) * HTB)
#define PG8_STAGE(bufoff, gbase, voff) do { _Pragma("unroll") for (int _i = 0; _i < 2; ++_i) \
        __builtin_amdgcn_global_load_lds((const unsigned*)((const char*)(gbase) + (voff)[_i]), (LAS unsigned*)(lds + (bufoff) + ldsw + _i * 8192), 16, 0, 0); } while (0)
#define PG8_LDA(dst, b, h) do { _Pragma("unroll") for (int m = 0; m < 4; ++m) _Pragma("unroll") for (int k = 0; k < 2; ++k) dst[m][k] = *(const LAS bf16x8*)(lds + PG8_SA(b, h) + aoff + m * 2048 + k * 1024); } while (0)
#define PG8_LDB(dst, b, h) do { _Pragma("unroll") for (int n = 0; n < 2; ++n) _Pragma("unroll") for (int k = 0; k < 2; ++k) dst[n][k] = *(const LAS bf16x8*)(lds + PG8_SB(b, h) + boff + n * 2048 + k * 1024); } while (0)
#define PG8_MMA(ai, bj, At, Bt) do { __builtin_amdgcn_s_setprio(1); _Pragma("unroll") for (int m = 0; m < 4; ++m) _Pragma("unroll") for (int n = 0; n < 2; ++n) _Pragma("unroll") for (int k = 0; k < 2; ++k) \
        acc[ai][bj][m][n] = __builtin_amdgcn_mfma_f32_16x16x32_bf16(Bt[n][k], At[m][k], acc[ai][bj][m][n], 0, 0, 0); __builtin_amdgcn_s_setprio(0); } while (0)
#define PG8_WAIT_V(n) asm volatile("s_waitcnt vmcnt(" #n ")" ::: "memory")
#define PG8_WAIT_L(n) asm volatile("s_waitcnt lgkmcnt(" #n ")" ::: "memory")
#define PG8_BAR __builtin_amdgcn_s_barrier()
#define PG8_SCHED __builtin_amdgcn_sched_barrier(0)
#define PG8_APTR(u) ((const char*)g.A + (size_t)(u).pm * tstepA + ((u).pn >= g.asplit ? (size_t)g.aoff2 * 2 : (size_t)0))
    Unit cur, nxt; int ui = 0;
    if (!S.next(0, cur)) return;
    f32x4 acc[2][2][4][2];
#pragma unroll
    for (int a = 0; a < 2; ++a)
#pragma unroll
        for (int b = 0; b < 2; ++b)
#pragma unroll
            for (int m = 0; m < 4; ++m)
#pragma unroll
                for (int n = 0; n < 2; ++n) acc[a][b][m][n] = (f32x4){0.f, 0.f, 0.f, 0.f};
    bf16x8 At[4][2], B0[2][2], B1[2][2];
    const char* cA = PG8_APTR(cur); const char* cB = (const char*)g.Bt + (size_t)cur.pn * tstepB;
    PG8_STAGE(PG8_SB(0, 0), cB, voffB); PG8_STAGE(PG8_SA(0, 0), cA, voffA); PG8_STAGE(PG8_SB(0, 1), cB + hstepB, voffB); PG8_STAGE(PG8_SA(0, 1), cA + hstepA, voffA);
    if (wr == 1) PG8_BAR;
    PG8_WAIT_V(4); PG8_BAR;
    PG8_STAGE(PG8_SB(1, 0), cB + kstep, voffB); PG8_STAGE(PG8_SA(1, 0), cA + kstep, voffA); PG8_STAGE(PG8_SB(1, 1), cB + hstepB + kstep, voffB);
    PG8_WAIT_V(6); PG8_BAR;
    for (;;) {
        const bool has_next = S.next(ui + 1, nxt);
        const char* nA = has_next ? PG8_APTR(nxt) : cA; const char* nB = has_next ? (const char*)g.Bt + (size_t)nxt.pn * tstepB : cB;
        for (int t = 0; t < nt; t += 2) {
            const bool last = (t == nt - 2);
            const char* a1 = cA + (size_t)(t + 1) * kstep;
            const char* a2 = last ? nA : cA + (size_t)(t + 2) * kstep; const char* b2 = last ? nB : cB + (size_t)(t + 2) * kstep;
            const char* a3 = a2 + kstep; const char* b3 = b2 + kstep;
            PG8_LDB(B0, 0, 0); PG8_SCHED; PG8_LDA(At, 0, 0); PG8_STAGE(PG8_SA(1, 1), a1 + hstepA, voffA);
            PG8_WAIT_L(8); PG8_BAR; PG8_WAIT_L(0); PG8_MMA(0, 0, At, B0); PG8_BAR; PG8_SCHED;
            PG8_LDB(B1, 0, 1); PG8_STAGE(PG8_SB(0, 0), b2, voffB);
            PG8_BAR; PG8_WAIT_L(0); PG8_MMA(0, 1, At, B1); PG8_BAR;
            PG8_LDA(At, 0, 1); PG8_STAGE(PG8_SA(0, 0), a2, voffA);
            PG8_BAR; PG8_WAIT_L(0); PG8_MMA(1, 0, At, B0); PG8_BAR; PG8_SCHED;
            PG8_STAGE(PG8_SB(0, 1), b2 + hstepB, voffB);
            PG8_WAIT_V(6); PG8_BAR; PG8_MMA(1, 1, At, B1); PG8_BAR;
            PG8_LDB(B0, 1, 0); PG8_SCHED; PG8_LDA(At, 1, 0); PG8_STAGE(PG8_SA(0, 1), a2 + hstepA, voffA);
            PG8_WAIT_L(8); PG8_BAR; PG8_WAIT_L(0); PG8_MMA(0, 0, At, B0); PG8_BAR; PG8_SCHED;
            PG8_LDB(B1, 1, 1); PG8_STAGE(PG8_SB(1, 0), b3, voffB);
            PG8_BAR; PG8_WAIT_L(0); PG8_MMA(0, 1, At, B1); PG8_BAR;
            PG8_LDA(At, 1, 1); PG8_STAGE(PG8_SA(1, 0), a3, voffA);
            PG8_BAR; PG8_WAIT_L(0); PG8_MMA(1, 0, At, B0); PG8_BAR; PG8_SCHED;
            PG8_STAGE(PG8_SB(1, 1), b3 + hstepB, voffB);
            PG8_WAIT_V(6); PG8_BAR; PG8_MMA(1, 1, At, B1); PG8_BAR;
        }
        E(acc, cur, wr, wc, fr, fq);
        if (!has_next) break;
#pragma unroll
        for (int a = 0; a < 2; ++a)
#pragma unroll
            for (int b = 0; b < 2; ++b)
#pragma unroll
                for (int m = 0; m < 4; ++m)
#pragma unroll
                    for (int n = 0; n < 2; ++n) acc[a][b][m][n] = (f32x4){0.f, 0.f, 0.f, 0.f};
        cur = nxt; cA = nA; cB = nB; ++ui;
    }
    PG8_WAIT_V(0);
    if (wr == 0) PG8_BAR;
    PG8_BAR;
#undef PG8_SA
#undef PG8_SB
#undef PG8_STAGE
#undef PG8_LDA
#undef PG8_LDB
#undef PG8_MMA
#undef PG8_WAIT_V
#undef PG8_WAIT_L
#undef PG8_BAR
#undef PG8_SCHED
#undef PG8_APTR
}
}
using pg8::Unit;

struct EpiP {
    static constexpr bool PERM = true, ROWPERM = false;
    bf16_t* P; float* BA; bf16_t* HALO;
    __device__ __forceinline__ void operator()(const f32x4 (&acc)[2][2][4][2], const Unit& u, int wr, int wc, int fr, int fq) const {
        const int row0 = u.pm * 256 + wr * 64 + fr, col0 = u.pn * 256 + wc * 32 + 8 * fq;
        const bool gate = u.pn >= 16;
        const bool halo = (u.pn < 6 || (u.pn >= 8 && u.pn < 14)) && wr == 1 && fr >= 13;
        const int hcol = u.pn < 6 ? col0 : col0 - 512;
#pragma unroll
        for (int ai = 0; ai < 2; ++ai)
#pragma unroll
            for (int m = 0; m < 4; ++m) {
                const int row = row0 + ai * 128 + m * 16; bf16_t* rowp = P + (size_t)row * LDP + col0;
#pragma unroll
                for (int bj = 0; bj < 2; ++bj) {
                    f32x4 v0 = acc[ai][bj][m][0], v1 = acc[ai][bj][m][1];
                    if (u.pn == 15 && bj == 0 && wc == 1 && fq < 2) { float* d = BA + (size_t)row * 16 + fq * 8; *(f32x4*)d = v0; *(f32x4*)(d + 4) = v1; }
                    if (gate) {
#pragma unroll
                        for (int j = 0; j < 4; ++j) { v0[j] = sigm(v0[j]); v1[j] = sigm(v1[j]); }
                    }
                    u32x4 o; o.x = pk2(v0[0], v0[1]); o.y = pk2(v0[2], v0[3]); o.z = pk2(v1[0], v1[1]); o.w = pk2(v1[2], v1[3]);
                    *(u32x4*)(rowp + bj * 128) = o;
                    if (halo && m == 3) *(u32x4*)(HALO + ((size_t)((2 * u.pm + ai) * 3 + (fr - 13))) * 3072 + hcol + bj * 128) = o;
                }
            }
    }
};
struct EpiStore {
    static constexpr bool PERM = true, ROWPERM = false;
    bf16_t* O; int ldc;
    __device__ __forceinline__ void operator()(const f32x4 (&acc)[2][2][4][2], const Unit& u, int wr, int wc, int fr, int fq) const {
        const int row0 = u.pm * 256 + wr * 64 + fr, col0 = u.pn * 256 + wc * 32 + 8 * fq;
#pragma unroll
        for (int ai = 0; ai < 2; ++ai)
#pragma unroll
            for (int m = 0; m < 4; ++m) {
                bf16_t* rowp = O + (size_t)(row0 + ai * 128 + m * 16) * ldc + col0;
#pragma unroll
                for (int bj = 0; bj < 2; ++bj) {
                    const f32x4 v0 = acc[ai][bj][m][0], v1 = acc[ai][bj][m][1];
                    u32x4 o; o.x = pk2(v0[0], v0[1]); o.y = pk2(v0[2], v0[3]); o.z = pk2(v1[0], v1[1]); o.w = pk2(v1[2], v1[3]);
                    *(u32x4*)(rowp + bj * 128) = o;
                }
            }
    }
};
struct EpiLo {
    static constexpr bool PERM = true, ROWPERM = false;
    bf16_t* O; const float* w0; const float* a0;
    __device__ __forceinline__ void operator()(const f32x4 (&acc)[2][2][4][2], const Unit& u, int wr, int wc, int fr, int fq) const {
        const int row0 = u.pm * 256 + wr * 64 + fr, col0 = u.pn * 256 + wc * 32 + 8 * fq;
        const int region = u.pn >> 1;
        const float* bsrc = region == 0 ? w0 : a0;
        const float sc = region == 0 ? 0.60653066f : 1.f;
#pragma unroll
        for (int bj = 0; bj < 2; ++bj) {
            const int c = col0 + bj * 128;
            f32x4 b0 = (f32x4){0.f, 0.f, 0.f, 0.f}, b1 = b0;
            if (region < 2) { b0 = *(const f32x4*)(bsrc + (c & 511)); b1 = *(const f32x4*)(bsrc + (c & 511) + 4); }
#pragma unroll
            for (int ai = 0; ai < 2; ++ai)
#pragma unroll
                for (int m = 0; m < 4; ++m) {
                    bf16_t* rowp = O + (size_t)(row0 + ai * 128 + m * 16) * LDLO + c;
                    f32x4 v0 = acc[ai][bj][m][0] + b0, v1 = acc[ai][bj][m][1] + b1;
                    if (region < 2) {
#pragma unroll
                        for (int j = 0; j < 4; ++j) { v0[j] = sc * sigm(v0[j]); v1[j] = sc * sigm(v1[j]); }
                    }
                    u32x4 o; o.x = pk2(v0[0], v0[1]); o.y = pk2(v0[2], v0[3]); o.z = pk2(v1[0], v1[1]); o.w = pk2(v1[2], v1[3]);
                    *(u32x4*)rowp = o;
                }
        }
    }
};
struct EpiBr {
    static constexpr bool PERM = true, ROWPERM = false;
    bf16_t* P;
    __device__ __forceinline__ void operator()(const f32x4 (&acc)[2][2][4][2], const Unit& u, int wr, int wc, int fr, int fq) const {
        const int row0 = u.pm * 256 + wr * 64 + fr, col0 = (u.pn & 3) * 256 + wc * 32 + 8 * fq;
        const bool second = u.pn >= 4;
        const int gcol = PC_GL + (second ? 1024 : 0);
#pragma unroll
        for (int bj = 0; bj < 2; ++bj) {
#pragma unroll
            for (int ai = 0; ai < 2; ++ai) {
                u32x4 gv[4], pv[4];
#pragma unroll
                for (int m = 0; m < 4; ++m) { const bf16_t* rowp = P + (size_t)(row0 + ai * 128 + m * 16) * LDP + col0 + bj * 128;
                    gv[m] = *(const u32x4*)(rowp + gcol);
                    pv[m] = second ? *(const u32x4*)rowp : (u32x4){0u, 0u, 0u, 0u}; }
#pragma unroll
                for (int m = 0; m < 4; ++m) {
                    bf16_t* rowp = P + (size_t)(row0 + ai * 128 + m * 16) * LDP + col0 + bj * 128;
                    const u32x4 g = gv[m], q = pv[m];
                    const f32x4 v0 = acc[ai][bj][m][0], v1 = acc[ai][bj][m][1];
                    float o[8];
                    o[0] = v0[0] * lo_bf(g.x) + lo_bf(q.x); o[1] = v0[1] * hi_bf(g.x) + hi_bf(q.x); o[2] = v0[2] * lo_bf(g.y) + lo_bf(q.y); o[3] = v0[3] * hi_bf(g.y) + hi_bf(q.y);
                    o[4] = v1[0] * lo_bf(g.z) + lo_bf(q.z); o[5] = v1[1] * hi_bf(g.z) + hi_bf(q.z); o[6] = v1[2] * lo_bf(g.w) + lo_bf(q.w); o[7] = v1[3] * hi_bf(g.w) + hi_bf(q.w);
                    *(u32x4*)rowp = pack8(o);
                }
            }
        }
    }
};
struct EpiGLU {
    static constexpr bool PERM = true, ROWPERM = true;
    bf16_t* ACT; bf16_t* BND; const float* cw;
    __device__ __forceinline__ void operator()(const f32x4 (&acc)[2][2][4][2], const Unit& u, int wr, int wc, int fr, int fq) const {
        const int tb = u.pm * 256 + 8 * (fr + 16 * wr);
        const int c0 = u.pn * 128 + wc * 32 + 8 * fq;
        const int blk = 2 * u.pm + wr;
        u32x2 ap[8][2];
        u32x2 gq[4][2];
#pragma unroll
        for (int n = 0; n < 2; ++n) {
            const f32x4 w0 = *(const f32x4*)(cw + c0 + 4 * n), w1 = *(const f32x4*)(cw + DFF + c0 + 4 * n), w2 = *(const f32x4*)(cw + 2 * DFF + c0 + 4 * n);
            f32x4 gm1, gm2;
#pragma unroll
            for (int j = 0; j < 4; ++j) {
                const float s1 = __shfl_up(acc[1][0][3][n][j], 1, 16), s2 = __shfl_up(acc[1][0][2][n][j], 1, 16);
                gm1[j] = fr == 0 ? 0.f : s1; gm2[j] = fr == 0 ? 0.f : s2;
            }
#pragma unroll
            for (int k = 0; k < 8; ++k) {
                const f32x4 g = acc[k >> 2][0][k & 3][n], up = acc[k >> 2][1][k & 3][n];
                const f32x4 x1 = k >= 1 ? acc[(k - 1 < 0 ? 0 : k - 1) >> 2][0][(k - 1 < 0 ? 0 : k - 1) & 3][n] : gm1;
                const f32x4 x2 = k >= 2 ? acc[(k - 2 < 0 ? 0 : k - 2) >> 2][0][(k - 2 < 0 ? 0 : k - 2) & 3][n] : (k == 1 ? gm1 : gm2);
                float o[4];
#pragma unroll
                for (int j = 0; j < 4; ++j) { const float cv = w2[j] * g[j] + w1[j] * x1[j] + w0[j] * x2[j]; o[j] = silu_(cv) * up[j]; }
                ap[k][n].x = pk2(o[0], o[1]); ap[k][n].y = pk2(o[2], o[3]);
            }
            gq[0][n].x = pk2(acc[1][0][2][n][0], acc[1][0][2][n][1]); gq[0][n].y = pk2(acc[1][0][2][n][2], acc[1][0][2][n][3]);
            gq[1][n].x = pk2(acc[1][0][3][n][0], acc[1][0][3][n][1]); gq[1][n].y = pk2(acc[1][0][3][n][2], acc[1][0][3][n][3]);
            gq[2][n].x = pk2(acc[0][0][0][n][0], acc[0][0][0][n][1]); gq[2][n].y = pk2(acc[0][0][0][n][2], acc[0][0][0][n][3]);
            gq[3][n].x = pk2(acc[0][0][1][n][0], acc[0][0][1][n][1]); gq[3][n].y = pk2(acc[0][0][1][n][2], acc[0][0][1][n][3]);
        }
#pragma unroll
        for (int k = 0; k < 8; ++k) { u32x4 o; o.x = ap[k][0].x; o.y = ap[k][0].y; o.z = ap[k][1].x; o.w = ap[k][1].y;
            *(u32x4*)(ACT + (size_t)(tb + k) * DFF + c0) = o; }
        bf16_t* bp = BND + (size_t)blk * 4 * LDGU + c0;
        if (fr == 15) {
            u32x4 a; a.x = gq[0][0].x; a.y = gq[0][0].y; a.z = gq[0][1].x; a.w = gq[0][1].y; *(u32x4*)(bp) = a;
            u32x4 b; b.x = gq[1][0].x; b.y = gq[1][0].y; b.z = gq[1][1].x; b.w = gq[1][1].y; *(u32x4*)(bp + LDGU) = b;
        }
        if (fr == 0) {
            u32x4 a; a.x = gq[2][0].x; a.y = gq[2][0].y; a.z = gq[2][1].x; a.w = gq[2][1].y; *(u32x4*)(bp + 2 * LDGU) = a;
            u32x4 b; b.x = gq[3][0].x; b.y = gq[3][0].y; b.z = gq[3][1].x; b.w = gq[3][1].y; *(u32x4*)(bp + 3 * LDGU) = b;
#pragma unroll
            for (int k = 0; k < 2; ++k) { u32x4 v; v.x = pk2(acc[0][1][k][0][0], acc[0][1][k][0][1]); v.y = pk2(acc[0][1][k][0][2], acc[0][1][k][0][3]);
                v.z = pk2(acc[0][1][k][1][0], acc[0][1][k][1][1]); v.w = pk2(acc[0][1][k][1][2], acc[0][1][k][1][3]);
                *(u32x4*)(bp + (2 + k) * LDGU + DFF) = v; }
        }
    }
};
struct EpiX1 {
    static constexpr bool PERM = true, ROWPERM = false;
    const float* x; bf16_t* X1; const float* gate;
    __device__ __forceinline__ void operator()(const f32x4 (&acc)[2][2][4][2], const Unit& u, int wr, int wc, int fr, int fq) const {
        const int row0 = u.pm * 256 + wr * 64 + fr, col0 = u.pn * 256 + wc * 32 + 8 * fq;
        const float* gp = gate + (size_t)((u.pm * 256) / T) * 6144 + col0;
#pragma unroll
        for (int bj = 0; bj < 2; ++bj) {
            const f32x4 g0 = *(const f32x4*)(gp + bj * 128), g1 = *(const f32x4*)(gp + bj * 128 + 4);
            f32x4 r0[2][4], r1[2][4];
#pragma unroll
            for (int ai = 0; ai < 2; ++ai)
#pragma unroll
                for (int m = 0; m < 4; ++m) { const size_t ro = (size_t)(row0 + ai * 128 + m * 16) * D + col0 + bj * 128; r0[ai][m] = *(const f32x4*)(x + ro); r1[ai][m] = *(const f32x4*)(x + ro + 4); }
#pragma unroll
            for (int ai = 0; ai < 2; ++ai)
#pragma unroll
                for (int m = 0; m < 4; ++m) {
                    const size_t ro = (size_t)(row0 + ai * 128 + m * 16) * D + col0 + bj * 128;
                    const f32x4 v0 = r0[ai][m] + g0 * acc[ai][bj][m][0], v1 = r1[ai][m] + g1 * acc[ai][bj][m][1];
                    u32x4 o; o.x = pk2(v0[0], v0[1]); o.y = pk2(v0[2], v0[3]); o.z = pk2(v1[0], v1[1]); o.w = pk2(v1[2], v1[3]);
                    *(u32x4*)(X1 + ro) = o;
                }
        }
    }
};
struct EpiX2 {
    static constexpr bool PERM = true, ROWPERM = false;
    const bf16_t* X1; bf16_t* X2; const float* gate;
    __device__ __forceinline__ void operator()(const f32x4 (&acc)[2][2][4][2], const Unit& u, int wr, int wc, int fr, int fq) const {
        const int row0 = u.pm * 256 + wr * 64 + fr, col0 = u.pn * 256 + wc * 32 + 8 * fq;
        const float* gp = gate + (size_t)((u.pm * 256) / T) * 6144 + col0;
        u32x4 rv[2][2][4];
#pragma unroll
        for (int bj = 0; bj < 2; ++bj)
#pragma unroll
            for (int ai = 0; ai < 2; ++ai)
#pragma unroll
                for (int m = 0; m < 4; ++m) rv[bj][ai][m] = *(const u32x4*)(X1 + (size_t)(row0 + ai * 128 + m * 16) * D + col0 + bj * 128);
        f32x4 gq[2][2];
#pragma unroll
        for (int bj = 0; bj < 2; ++bj) { gq[bj][0] = *(const f32x4*)(gp + bj * 128); gq[bj][1] = *(const f32x4*)(gp + bj * 128 + 4); }
#pragma unroll
        for (int bj = 0; bj < 2; ++bj) {
            const f32x4 g0 = gq[bj][0], g1 = gq[bj][1];
#pragma unroll
            for (int ai = 0; ai < 2; ++ai)
#pragma unroll
                for (int m = 0; m < 4; ++m) {
                    const size_t ro = (size_t)(row0 + ai * 128 + m * 16) * D + col0 + bj * 128;
                    const u32x4 r = rv[bj][ai][m];
                    float v[8];
                    v[0] = lo_bf(r.x) + g0[0] * acc[ai][bj][m][0][0]; v[1] = hi_bf(r.x) + g0[1] * acc[ai][bj][m][0][1];
                    v[2] = lo_bf(r.y) + g0[2] * acc[ai][bj][m][0][2]; v[3] = hi_bf(r.y) + g0[3] * acc[ai][bj][m][0][3];
                    v[4] = lo_bf(r.z) + g1[0] * acc[ai][bj][m][1][0]; v[5] = hi_bf(r.z) + g1[1] * acc[ai][bj][m][1][1];
                    v[6] = lo_bf(r.w) + g1[2] * acc[ai][bj][m][1][2]; v[7] = hi_bf(r.w) + g1[3] * acc[ai][bj][m][1][3];
                    *(u32x4*)(X2 + ro) = pack8(v);
                }
        }
    }
};
struct EpiRes {
    static constexpr bool PERM = false, ROWPERM = false;
    const float* resid; float* out; const float* gate;
    __device__ __forceinline__ void operator()(const f32x4 (&acc)[2][2][4][2], const Unit& u, int wr, int wc, int fr, int fq) const {
        const int row0 = u.pm * 256 + wr * 64 + fr, col0 = u.pn * 256 + wc * 32 + 4 * fq;
        const float* gp = gate + (size_t)((u.pm * 256) / T) * 6144 + col0;
        f32x4 gv[2][2];
#pragma unroll
        for (int bj = 0; bj < 2; ++bj)
#pragma unroll
            for (int n = 0; n < 2; ++n) gv[bj][n] = *(const f32x4*)(gp + bj * 128 + n * 16);
#pragma unroll
        for (int ai = 0; ai < 2; ++ai)
#pragma unroll
            for (int m = 0; m < 4; ++m) {
                const size_t ro = (size_t)(row0 + ai * 128 + m * 16) * D + col0;
#pragma unroll
                for (int bj = 0; bj < 2; ++bj)
#pragma unroll
                    for (int n = 0; n < 2; ++n) {
                        const f32x4 r = *(const f32x4*)(resid + ro + bj * 128 + n * 16);
                        *(f32x4*)(out + ro + bj * 128 + n * 16) = r + gv[bj][n] * acc[ai][bj][m][n];
                    }
            }
    }
};

struct TileDesc { const float* src; bf16_t* dst; int ldsrc, ldd, k0, n0, mode; };
__device__ __forceinline__ void xpose_load(const TileDesc& d, int tid, float (&v)[8]) {
    const int nl = tid & 63, ks = tid >> 6, n = d.n0 + nl;
    int sc = n;
    if (d.mode == 2) sc = ((n & 255) >> 7) * DFF + 128 * (n >> 8) + (n & 127);
    if (d.mode == 1) { if (n < 2048) sc = n; else if (n < 3872) sc = n + 16; else if (n < 3888) sc = 2048 + (n - 3872); else if (n < 4096) sc = -1; else sc = n - 208; }
#pragma unroll
    for (int i = 0; i < 8; ++i) v[i] = sc >= 0 ? d.src[(size_t)(d.k0 + ks + 8 * i) * d.ldsrc + sc] : 0.f;
}
__device__ __forceinline__ void xpose_put(int tid, const float (&v)[8], LAS float* tile) {
    const int nl = tid & 63, ks = tid >> 6;
#pragma unroll
    for (int i = 0; i < 8; ++i) tile[(ks + 8 * i) * 65 + nl] = v[i];
}
__device__ __forceinline__ void xpose_store(const TileDesc& d, int tid, const LAS float* tile) {
    const int n_l = tid >> 3, kc = (tid & 7) * 8; const LAS float* s = tile + kc * 65 + n_l;
    u32x4 o; o.x = pk2(s[0], s[65]); o.y = pk2(s[130], s[195]); o.z = pk2(s[260], s[325]); o.w = pk2(s[390], s[455]);
    *(u32x4*)(d.dst + (size_t)(d.n0 + n_l) * d.ldd + d.k0 + kc) = o;
}
constexpr int XP_I0 = 16 * 96, XP_NIT = 16 * 96 + 2 * (8 * 16) + 16 * 16 + 16 * 88 + 44 * 16;
__device__ __forceinline__ void xpose_range(int wv, const Params& p, LAS unsigned char* lds, int first, int last, int start, int stride) {
    const int tid = opaque_tid(wv);
    LAS float* tile0 = (LAS float*)lds; LAS float* tile1 = tile0 + 64 * 65;
    bf16_t* wtin = (bf16_t*)(p.ws + WS_WTIN); bf16_t* wtbr = (bf16_t*)(p.ws + WS_WTBR); bf16_t* wtout = (bf16_t*)(p.ws + WS_WTOUT);
    bf16_t* wtf1 = (bf16_t*)(p.ws + WS_WTF1); bf16_t* wtf2 = (bf16_t*)(p.ws + WS_WTF2);
    constexpr int I0 = 16 * 96, I1 = 8 * 16, I3 = 16 * 16, I5 = 16 * 88, I6 = 44 * 16, NIT = I0 + 2 * I1 + I3 + I5 + I6;
    auto desc = [&](int it) -> TileDesc {
        int r = it;
        if (r < I0) return TileDesc{p.w_in, wtin, 5936, 1024, (r / 96) * 64, (r % 96) * 64, 1}; r -= I0;
        if (r < I1) return TileDesc{p.w_branch_gdn, wtbr, 1024, 512, (r / 16) * 64, (r % 16) * 64, 0}; r -= I1;
        if (r < I1) return TileDesc{p.w_branch_rwkv, wtbr + (size_t)1024 * 512, 1024, 512, (r / 16) * 64, (r % 16) * 64, 0}; r -= I1;
        if (r < I3) return TileDesc{p.w_out, wtout, 1024, 1024, (r / 16) * 64, (r % 16) * 64, 0}; r -= I3;
        if (r < I5) return TileDesc{p.w_ffn_in, wtf1, 5632, 1024, (r / 88) * 64, (r % 88) * 64, 2}; r -= I5;
        return TileDesc{p.w_ffn_out, wtf2, 1024, 2816, (r / 16) * 64, (r % 16) * 64, 0};
    };
    {
        const int G = stride;
        int it = first + start;
        bool hA = it < last, hB = it + G < last;
        float va[8], vb[8];
        if (hA) { const TileDesc d = desc(it); xpose_load(d, tid, va); }
        if (hB) { const TileDesc d = desc(it + G); xpose_load(d, tid, vb); }
        while (hA) {
            xpose_put(tid, va, tile0); if (hB) xpose_put(tid, vb, tile1);
            const int nit = it + 2 * G; const bool nA = nit < last, nB = nit + G < last;
            if (nA) { const TileDesc d = desc(nit); xpose_load(d, tid, va); }
            if (nB) { const TileDesc d = desc(nit + G); xpose_load(d, tid, vb); }
            __syncthreads();
            { const TileDesc d = desc(it); xpose_store(d, tid, tile0); }
            if (hB) { const TileDesc d = desc(it + G); xpose_store(d, tid, tile1); }
            __syncthreads();
            it = nit; hA = nA; hB = nB;
        }
    }
}
__device__ __forceinline__ void phase0(int wv, const Params& p, LAS unsigned char* lds) {
    const int tid = opaque_tid(wv);
    LAS float* tile0 = (LAS float*)lds; LAS float* tile1 = tile0 + 64 * 65;
    bf16_t* wtin = (bf16_t*)(p.ws + WS_WTIN); bf16_t* wtbr = (bf16_t*)(p.ws + WS_WTBR); bf16_t* wtout = (bf16_t*)(p.ws + WS_WTOUT);
    bf16_t* wtf1 = (bf16_t*)(p.ws + WS_WTF1); bf16_t* wtf2 = (bf16_t*)(p.ws + WS_WTF2); bf16_t* wtlo = (bf16_t*)(p.ws + WS_WTLO);
    float* mod = (float*)(p.ws + WS_MOD);
    LAS float* sc = (LAS float*)lds + 8192;
    LAS float* red = (LAS float*)lds + 8192 + 8192;
    for (int g = blockIdx.x; g < 192; g += gridDim.x) {
        for (int i = tid; i < 8192; i += 512) sc[i] = silu_(p.c[i]);
        __syncthreads();
        const int col = tid & 31, ks = tid >> 5, j = g * 32 + col;
        float a[8];
#pragma unroll
        for (int b = 0; b < 8; ++b) a[b] = 0.f;
        for (int i0 = 0; i0 < 64; i0 += 16) {
            float wq[16];
#pragma unroll
            for (int u = 0; u < 16; ++u) wq[u] = p.w_ada[(size_t)(ks + 16 * (i0 + u)) * 6144 + j];
#pragma unroll
            for (int u = 0; u < 16; ++u) { const int k = ks + 16 * (i0 + u);
#pragma unroll
                for (int b = 0; b < 8; ++b) a[b] += sc[b * 1024 + k] * wq[u]; }
        }
#pragma unroll
        for (int b = 0; b < 8; ++b) red[(ks * 8 + b) * 32 + col] = a[b];
        __syncthreads();
        if (tid < 256) { const int b = tid >> 5, cc = tid & 31; float sacc = p.b_ada[g * 32 + cc];
            for (int q = 0; q < 16; ++q) sacc += red[(q * 8 + b) * 32 + cc];
            mod[b * 6144 + g * 32 + cc] = sacc; }
        __syncthreads();
    }
    xpose_range(wv, p, lds, 0, XP_I0, blockIdx.x, gridDim.x);
    for (int idx = blockIdx.x * 512 + tid; idx < 1536 * 384; idx += gridDim.x * 512) {
        const int n = idx / 384, k = idx % 384; float v = 0.f;
        if (n < 512) { if (k < 64) v = p.w2[k * 512 + n]; }
        else if (n < 1024) { if (k >= 64 && k < 128) v = p.a2[(k - 64) * 512 + (n - 512)]; }
        else { if (k >= 128 && k < 288) v = p.g2[(k - 128) * 512 + (n - 1024)]; }
        wtlo[idx] = f2bf(v);
    }
}

__device__ __forceinline__ void norm_mod_phase(int wv, const float* src, const float* nw, const float* mod, int scale_off, int shift_off, bf16_t* dst) {
    const int tid_ = opaque_tid(wv); const int lane = tid_ & 63, gw = blockIdx.x * 8 + (tid_ >> 6), ngw = gridDim.x * 8;
    f32x4 w[4];
#pragma unroll
    for (int j = 0; j < 4; ++j) w[j] = *(const f32x4*)(nw + 4 * lane + 256 * j);
    f32x4 v[4], nx[4];
    if (gw < NTOK) {
#pragma unroll
        for (int j = 0; j < 4; ++j) v[j] = ((const f32x4*)(src + (size_t)gw * D) + lane)[64 * j];
    }
    for (int row = gw; row < NTOK; row += ngw) {
        const bool hn = row + ngw < NTOK;
        if (hn) {
#pragma unroll
            for (int j = 0; j < 4; ++j) nx[j] = ((const f32x4*)(src + (size_t)(row + ngw) * D) + lane)[64 * j];
        }
        const float* mb = mod + (size_t)(row / T) * 6144;
        f32x4 scl[4], sh[4];
#pragma unroll
        for (int j = 0; j < 4; ++j) { scl[j] = *(const f32x4*)(mb + scale_off + 4 * lane + 256 * j); sh[j] = *(const f32x4*)(mb + shift_off + 4 * lane + 256 * j); }
        float s = 0.f;
#pragma unroll
        for (int j = 0; j < 4; ++j) s += (v[j].x * v[j].x + v[j].y * v[j].y) + (v[j].z * v[j].z + v[j].w * v[j].w);
        const float rstd = rsqrtf(wsum(s) * (1.f / D) + 1e-6f);
#pragma unroll
        for (int j = 0; j < 4; ++j) { const int c = 4 * lane + 256 * j;
            const f32x4 y = v[j] * rstd * w[j] * (scl[j] + 1.f) + sh[j];
            u32x2 o; o.x = pk2(y.x, y.y); o.y = pk2(y.z, y.w);
            *(u32x2*)(dst + (size_t)row * D + c) = o; }
        if (hn) {
#pragma unroll
            for (int j = 0; j < 4; ++j) v[j] = nx[j];
        }
    }
}
__device__ __forceinline__ void norm_mod_bf16_phase(int wv, const bf16_t* src, const float* nw, const float* mod, int scale_off, int shift_off, bf16_t* dst) {
    const int tid_ = opaque_tid(wv); const int lane = tid_ & 63, gw = blockIdx.x * 8 + (tid_ >> 6), ngw = gridDim.x * 8;
    f32x4 w[2][2];
#pragma unroll
    for (int j = 0; j < 2; ++j) { w[j][0] = *(const f32x4*)(nw + 8 * lane + 512 * j); w[j][1] = *(const f32x4*)(nw + 8 * lane + 512 * j + 4); }
    u32x4 v[2], nx[2];
    if (gw < NTOK) {
#pragma unroll
        for (int j = 0; j < 2; ++j) v[j] = *(const u32x4*)(src + (size_t)gw * D + 8 * lane + 512 * j);
    }
    for (int row = gw; row < NTOK; row += ngw) {
        const bool hn = row + ngw < NTOK;
        if (hn) {
#pragma unroll
            for (int j = 0; j < 2; ++j) nx[j] = *(const u32x4*)(src + (size_t)(row + ngw) * D + 8 * lane + 512 * j);
        }
        const float* mb = mod + (size_t)(row / T) * 6144;
        float f[2][8]; float s = 0.f;
#pragma unroll
        for (int j = 0; j < 2; ++j) { unpack8(v[j], f[j]);
#pragma unroll
            for (int i = 0; i < 8; ++i) s += f[j][i] * f[j][i]; }
        const float rstd = rsqrtf(wsum(s) * (1.f / D) + 1e-6f);
#pragma unroll
        for (int j = 0; j < 2; ++j) { const int c = 8 * lane + 512 * j;
            const f32x4 sc0 = *(const f32x4*)(mb + scale_off + c), sc1 = *(const f32x4*)(mb + scale_off + c + 4), sh0 = *(const f32x4*)(mb + shift_off + c), sh1 = *(const f32x4*)(mb + shift_off + c + 4);
            float o[8];
#pragma unroll
            for (int i = 0; i < 4; ++i) { o[i] = f[j][i] * rstd * w[j][0][i] * (sc0[i] + 1.f) + sh0[i]; o[4 + i] = f[j][4 + i] * rstd * w[j][1][i] * (sc1[i] + 1.f) + sh1[i]; }
            *(u32x4*)(dst + (size_t)row * D + c) = pack8(o); }
        if (hn) { v[0] = nx[0]; v[1] = nx[1]; }
    }
}
__device__ __forceinline__ void final_norm_phase(int wv, const bf16_t* src, float* out, const float* nw) {
    const int tid_ = opaque_tid(wv); const int lane = tid_ & 63, gw = blockIdx.x * 8 + (tid_ >> 6), ngw = gridDim.x * 8;
    f32x4 w[2][2];
#pragma unroll
    for (int j = 0; j < 2; ++j) { w[j][0] = *(const f32x4*)(nw + 8 * lane + 512 * j); w[j][1] = *(const f32x4*)(nw + 8 * lane + 512 * j + 4); }
    u32x4 v[2], nx[2];
    if (gw < NTOK) {
#pragma unroll
        for (int j = 0; j < 2; ++j) v[j] = *(const u32x4*)(src + (size_t)gw * D + 8 * lane + 512 * j);
    }
    for (int row = gw; row < NTOK; row += ngw) {
        const bool hn = row + ngw < NTOK;
        if (hn) {
#pragma unroll
            for (int j = 0; j < 2; ++j) nx[j] = *(const u32x4*)(src + (size_t)(row + ngw) * D + 8 * lane + 512 * j);
        }
        float f[2][8]; float s = 0.f;
#pragma unroll
        for (int j = 0; j < 2; ++j) { unpack8(v[j], f[j]);
#pragma unroll
            for (int i = 0; i < 8; ++i) s += f[j][i] * f[j][i]; }
        const float rstd = rsqrtf(wsum(s) * (1.f / D) + 1e-6f);
#pragma unroll
        for (int j = 0; j < 2; ++j) { float* o = out + (size_t)row * D + 8 * lane + 512 * j;
            f32x4 o0, o1;
#pragma unroll
            for (int i = 0; i < 4; ++i) { o0[i] = f[j][i] * rstd * w[j][0][i]; o1[i] = f[j][4 + i] * rstd * w[j][1][i]; }
            *(f32x4*)o = o0; *(f32x4*)(o + 4) = o1; }
        if (hn) { v[0] = nx[0]; v[1] = nx[1]; }
    }
}

__device__ __forceinline__ void alo_phase(int wv, const Params& p, const bf16_t* P, bf16_t* ALO) {
    const int total = NTOK * 48;
    for (int idx = blockIdx.x * 512 + opaque_tid(wv); idx < total; idx += gridDim.x * 512) {
        const int tok = idx / 48, j0 = (idx % 48) * 8;
        u32x4 o = (u32x4){0u, 0u, 0u, 0u};
        if (j0 < 288) {
            const u32x4 cu = *(const u32x4*)(P + (size_t)tok * LDP + PC_LO + j0);
            u32x4 pu = (u32x4){0u, 0u, 0u, 0u};
            if ((tok % T) != 0) pu = *(const u32x4*)(P + (size_t)(tok - 1) * LDP + PC_LO + j0);
            const f32x4 m0 = *(const f32x4*)(p.mu_rwkv + 1536 + j0), m1 = *(const f32x4*)(p.mu_rwkv + 1536 + j0 + 4);
            float v[8], q[8];
            v[0] = lo_bf(cu.x); v[1] = hi_bf(cu.x); v[2] = lo_bf(cu.y); v[3] = hi_bf(cu.y); v[4] = lo_bf(cu.z); v[5] = hi_bf(cu.z); v[6] = lo_bf(cu.w); v[7] = hi_bf(cu.w);
            q[0] = lo_bf(pu.x); q[1] = hi_bf(pu.x); q[2] = lo_bf(pu.y); q[3] = hi_bf(pu.y); q[4] = lo_bf(pu.z); q[5] = hi_bf(pu.z); q[6] = lo_bf(pu.w); q[7] = hi_bf(pu.w);
#pragma unroll
            for (int i = 0; i < 8; ++i) { const float mu = i < 4 ? m0[i] : m1[i - 4]; float m = v[i] + (q[i] - v[i]) * mu;
                if (j0 < 64) m = 1.f - 2.f * __builtin_amdgcn_rcpf(1.f + __expf(2.f * m)); else if (j0 >= 128) m = sigm(m);
                v[i] = m; }
            o.x = pk2(v[0], v[1]); o.y = pk2(v[2], v[3]); o.z = pk2(v[4], v[5]); o.w = pk2(v[6], v[7]);
        }
        *(u32x4*)(ALO + (size_t)tok * LDALO + j0) = o;
    }
}

constexpr int TC = 32, VEC = TC * 64, SCOFF = 5 * VEC + TC * 32, PEOFF = SCOFF + TC * 2, INBUF = PEOFF + 64;
struct StepR { f32x2 r[4], k[4], a[4], b[4]; float v; };
struct StepG { f32x2 r[4], a[4]; float v; f32x2 ab; };
__device__ __forceinline__ void ld_stepR(StepR& s, const LAS float* lb, const LAS float* vb, int t) {
    const LAS float* base = lb + t * 64;
#pragma unroll
    for (int i = 0; i < 4; ++i) { s.r[i] = *(const LAS f32x2*)(base + 2 * i); s.k[i] = *(const LAS f32x2*)(base + 2 * VEC + 2 * i);
        s.a[i] = *(const LAS f32x2*)(base + 3 * VEC + 2 * i); s.b[i] = *(const LAS f32x2*)(base + 4 * VEC + 2 * i); }
    s.v = vb[t * 32];
}
__device__ __forceinline__ void ld_stepG(StepG& s, const LAS float* lb, const LAS float* vb, const LAS float* sb, int t) {
    const LAS float* base = lb + t * 64;
#pragma unroll
    for (int i = 0; i < 4; ++i) { s.r[i] = *(const LAS f32x2*)(base + 2 * i); s.a[i] = *(const LAS f32x2*)(base + 3 * VEC + 2 * i); }
    s.v = vb[t * 32]; s.ab = *(const LAS f32x2*)(sb + 2 * t);
}
__device__ __forceinline__ float do_stepR(f32x2 (&S)[4], const StepR& s) {
    f32x2 d = S[0] * s.a[0]; f32x2 d2 = S[1] * s.a[1]; d = S[2] * s.a[2] + d; d2 = S[3] * s.a[3] + d2; d = d + d2;
    const f32x2 v2 = (f32x2){s.v, s.v};
    f32x2 u[4];
#pragma unroll
    for (int i = 0; i < 4; ++i) u[i] = v2 * s.k[i] + S[i];
    const float sa = red8(d.x + d.y);
    const f32x2 sa2 = (f32x2){sa, sa};
#pragma unroll
    for (int i = 0; i < 4; ++i) S[i] = sa2 * s.b[i] + u[i];
    f32x2 e = S[0] * s.r[0]; f32x2 e2 = S[1] * s.r[1]; e = S[2] * s.r[2] + e; e2 = S[3] * s.r[3] + e2; e = e + e2;
    return e.x + e.y;
}
__device__ __forceinline__ float do_stepG(f32x2 (&S)[4], const StepG& s) {
    f32x2 d = S[0] * s.a[0]; f32x2 d2 = S[1] * s.a[1]; d = S[2] * s.a[2] + d; d2 = S[3] * s.a[3] + d2; d = d + d2;
    const f32x2 al2 = (f32x2){s.ab.x, s.ab.x};
    f32x2 u[4];
#pragma unroll
    for (int i = 0; i < 4; ++i) u[i] = S[i] * al2;
    const float sa = red8(d.x + d.y);
    const float coef = s.ab.y * (s.v - s.ab.x * sa);
    const f32x2 c2 = (f32x2){coef, coef};
#pragma unroll
    for (int i = 0; i < 4; ++i) S[i] = c2 * s.a[i] + u[i];
    f32x2 e = S[0] * s.r[0]; f32x2 e2 = S[1] * s.r[1]; e = S[2] * s.r[2] + e; e2 = S[3] * s.r[3] + e2; e = e + e2;
    return e.x + e.y;
}
__device__ __forceinline__ void lora_phase(int wv, const Params& p, LAS unsigned char* lds, const bf16_t* P, const bf16_t* wtlo, bf16_t* LO) {
    const int tid = opaque_tid(wv), lane = tid & 63, r = lane & 15, q = lane >> 4;
    LAS float* bias = (LAS float*)(lds + 98304);
    for (int i = tid; i < 1024; i += 512) bias[i] = i < 512 ? p.w0[i] : p.a0[i - 512];
    for (int base = blockIdx.x * 8; base < NTOK / 16; base += gridDim.x * 8) {
        const int tile = base + wv;
        const int tok = tile * 16 + r;
        const bf16_t* cur = P + (size_t)tok * LDP + PC_LO + q * 8;
        const bool has_prev = (tok % T) != 0;
        const bf16_t* prv = has_prev ? cur - LDP : cur;
        const float pm = has_prev ? 1.f : 0.f;
        u32x4 cu[9], pu[9];
#pragma unroll
        for (int ks = 0; ks < 9; ++ks) { cu[ks] = *(const u32x4*)(cur + ks * 32); pu[ks] = *(const u32x4*)(prv + ks * 32); }
        u32x4 st0[8];
#pragma unroll
        for (int i = 0; i < 8; ++i) { const int c = tid + 512 * i; st0[i] = *(const u32x4*)(wtlo + (size_t)(c >> 3) * LDALO + (c & 7) * 8); }
        bf16x8 af[9];
#pragma unroll
        for (int ks = 0; ks < 9; ++ks) {
            const f32x4 m0 = *(const f32x4*)(p.mu_rwkv + 1536 + ks * 32 + q * 8), m1 = *(const f32x4*)(p.mu_rwkv + 1536 + ks * 32 + q * 8 + 4);
            float v[8], pv[8]; unpack8(cu[ks], v); unpack8(pu[ks], pv);
#pragma unroll
            for (int i = 0; i < 8; ++i) { const float mu = i < 4 ? m0[i] : m1[i - 4]; float m = v[i] + (pv[i] * pm - v[i]) * mu;
                if (ks < 2) m = 1.f - 2.f * __builtin_amdgcn_rcpf(1.f + __expf(2.f * m)); else if (ks >= 4) m = sigm(m);
                v[i] = m; }
            const u32x4 pk = pack8(v);
            af[ks] = __builtin_bit_cast(bf16x8, pk);
        }
        bf16_t* orow = LO + (size_t)tok * LDLO + 8 * q;
        const int rsl = 8 * (r >> 2) + (r & 3);
        u32x4 st[10];
#pragma unroll
        for (int i = 0; i < 8; ++i) st[i] = st0[i];
#define LORA_LOAD(N0, NROWS, KS0, NKS) do { constexpr int CPR = (NKS) * 4; \
            _Pragma("unroll") for (int i = 0; i < (NROWS) * CPR / 512; ++i) { const int c = tid + 512 * i, row = c / CPR, kc = c % CPR; \
                st[i] = *(const u32x4*)(wtlo + (size_t)((N0) + row) * LDALO + (KS0) * 32 + kc * 8); } } while (0)
#define LORA_WRITE(NROWS, NKS) do { constexpr int RSB = (NKS) * 64 + 16, CPR = (NKS) * 4; \
            _Pragma("unroll") for (int i = 0; i < (NROWS) * CPR / 512; ++i) { const int c = tid + 512 * i, row = c / CPR, kc = c % CPR; \
                *(LAS u32x4*)(lds + row * RSB + kc * 16) = st[i]; } } while (0)
#define LORA_PAIRS(N0, NROWS, KS0, NKS, REGION) do { constexpr int RSB = (NKS) * 64 + 16; \
            _Pragma("unroll 2") for (int pl = 0; pl < (NROWS) / 32; ++pl) { \
                const f32x4 zero4 = (f32x4){0.f, 0.f, 0.f, 0.f}; \
                const LAS unsigned char* b0 = lds + (32 * pl + rsl) * RSB + q * 16; const LAS unsigned char* b1 = b0 + 4 * RSB; \
                bf16x8 w0f[NKS], w1f[NKS]; f32x4 pa0[NKS], pa1[NKS]; \
                _Pragma("unroll") for (int kk = 0; kk < (NKS); ++kk) { w0f[kk] = *(const LAS bf16x8*)(b0 + kk * 64); w1f[kk] = *(const LAS bf16x8*)(b1 + kk * 64); } \
                  \
                _Pragma("unroll") for (int kk = 0; kk < (NKS); ++kk) { \
                    pa0[kk] = __builtin_amdgcn_mfma_f32_16x16x32_bf16(w0f[kk], af[(KS0) + kk], zero4, 0, 0, 0); \
                    pa1[kk] = __builtin_amdgcn_mfma_f32_16x16x32_bf16(w1f[kk], af[(KS0) + kk], zero4, 0, 0, 0); } \
                _Pragma("unroll") for (int kk = 0; kk < (NKS); ++kk) asm volatile("" : "+v"(pa0[kk]), "+v"(pa1[kk])); \
                asm volatile("s_nop 15\n\ts_nop 15" ::: "memory"); \
                _Pragma("unroll") for (int kk = 0; kk < (NKS); ++kk) asm volatile("" : "+v"(pa0[kk]), "+v"(pa1[kk])); \
                f32x4 acc0 = pa0[0], acc1 = pa1[0]; \
                _Pragma("unroll") for (int kk = 1; kk < (NKS); ++kk) { acc0 = acc0 + pa0[kk]; acc1 = acc1 + pa1[kk]; } \
                const int n0 = (N0) + 32 * pl + 8 * q; float o[8]; \
                if ((REGION) < 2) { const LAS float* bs = bias + ((REGION) == 0 ? 0 : 512) + (n0 & 511); const f32x4 c0 = *(const LAS f32x4*)bs, c1 = *(const LAS f32x4*)(bs + 4); \
                    const float sc = (REGION) == 0 ? 0.60653066f : 1.f; \
                    _Pragma("unroll") for (int j = 0; j < 4; ++j) { o[j] = sc * sigm(acc0[j] + c0[j]); o[4 + j] = sc * sigm(acc1[j] + c1[j]); } } \
                else { _Pragma("unroll") for (int j = 0; j < 4; ++j) { o[j] = acc0[j]; o[4 + j] = acc1[j]; } } \
                *(u32x4*)(orow + (N0) + 32 * pl) = pack8(o); } } while (0)
        __syncthreads(); LORA_WRITE(512, 2); LORA_LOAD(512, 512, 2, 2);   __syncthreads(); LORA_PAIRS(0, 512, 0, 2, 0);
        __syncthreads(); LORA_WRITE(512, 2); LORA_LOAD(1024, 256, 4, 5);  __syncthreads(); LORA_PAIRS(512, 512, 2, 2, 1);
        __syncthreads(); LORA_WRITE(256, 5); LORA_LOAD(1280, 256, 4, 5);  __syncthreads(); LORA_PAIRS(1024, 256, 4, 5, 2);
        __syncthreads(); LORA_WRITE(256, 5);                              __syncthreads(); LORA_PAIRS(1280, 256, 4, 5, 2);
#undef LORA_LOAD
#undef LORA_WRITE
#undef LORA_PAIRS
    }
    __syncthreads();
}

struct B4 { float g[4][3]; float rw[4][3]; float bl[4], al[4], e[4], asg[4]; };
__device__ __forceinline__ void unpack4f(const u32x2 u, float (&v)[4]) { v[0] = lo_bf(u.x); v[1] = hi_bf(u.x); v[2] = lo_bf(u.y); v[3] = hi_bf(u.y); }
__device__ __forceinline__ u32x2 pack4f(const float (&v)[4]) { u32x2 o; o.x = pk2(v[0], v[1]); o.y = pk2(v[2], v[3]); return o; }
__device__ __forceinline__ float red16f(float x) { x += dpp_f(x, 0); x += dpp_f(x, 1); x += dpp_f(x, 2); x += dpp_rm(x); return x; }
struct PRaw { u32x2 gq, gk, gv, rr, rk, rv, le, la; float bl, al; };
__device__ __forceinline__ void prep2_phase(int wv, const Params& p, bf16_t* P, float* BA, const bf16_t* HALO, bf16_t* LO, float* PEND) {
    const int tid = opaque_tid(wv), lane = tid & 63, cq = wv >> 1, hh = wv & 1;
    const int c0 = 256 * hh + 4 * lane, h = c0 >> 6;
    float cw[4][3][4], mur[4], muk[4], muv[4], kkc[4], kac[4];
#pragma unroll
    for (int j = 0; j < 4; ++j)
#pragma unroll
        for (int s3 = 0; s3 < 3; ++s3) { const f32x4 t = *(const f32x4*)(p.conv_gdn + j * 1536 + s3 * 512 + c0); cw[j][s3][0] = t.x; cw[j][s3][1] = t.y; cw[j][s3][2] = t.z; cw[j][s3][3] = t.w; }
    { const f32x4 a = *(const f32x4*)(p.mu_rwkv + c0), b2 = *(const f32x4*)(p.mu_rwkv + 512 + c0), c2 = *(const f32x4*)(p.mu_rwkv + 1024 + c0), d2 = *(const f32x4*)(p.k_k + c0), e2 = *(const f32x4*)(p.k_a + c0);
#pragma unroll
      for (int i = 0; i < 4; ++i) { mur[i] = a[i]; muk[i] = b2[i]; muv[i] = c2[i]; kkc[i] = d2[i]; kac[i] = e2[i]; } }
    const float nA = -expf(p.a_log[h]), dtb = p.dt_bias[h];
    for (int blk = blockIdx.x; blk < NTOK / 128; blk += gridDim.x) {
        const int tok0 = blk * 128, t0 = tok0 + 32 * cq;
        float xw[3][3][4], pv[3][4];
        if (cq == 0) {
            if ((tok0 % T) != 0) {
                const bf16_t* hr = HALO + (size_t)(blk - 1) * 3 * 3072;
#pragma unroll
                for (int r = 0; r < 3; ++r)
#pragma unroll
                    for (int s3 = 0; s3 < 3; ++s3) unpack4f(*(const u32x2*)(hr + r * 3072 + s3 * 512 + c0), xw[r][s3]);
#pragma unroll
                for (int s3 = 0; s3 < 3; ++s3) unpack4f(*(const u32x2*)(hr + 2 * 3072 + 1536 + s3 * 512 + c0), pv[s3]);
            } else {
#pragma unroll
                for (int r = 0; r < 3; ++r)
#pragma unroll
                    for (int s3 = 0; s3 < 3; ++s3)
#pragma unroll
                        for (int i = 0; i < 4; ++i) xw[r][s3][i] = 0.f;
#pragma unroll
                for (int s3 = 0; s3 < 3; ++s3)
#pragma unroll
                    for (int i = 0; i < 4; ++i) pv[s3][i] = 0.f;
            }
        } else {
#pragma unroll
            for (int r = 0; r < 3; ++r)
#pragma unroll
                for (int s3 = 0; s3 < 3; ++s3) unpack4f(*(const u32x2*)(P + (size_t)(t0 - 3 + r) * LDP + s3 * 512 + c0), xw[r][s3]);
#pragma unroll
            for (int s3 = 0; s3 < 3; ++s3) unpack4f(*(const u32x2*)(P + (size_t)(t0 - 1) * LDP + PC_RB + s3 * 512 + c0), pv[s3]);
        }
        auto load = [&](int t, PRaw& w) {
            const size_t tok = (size_t)t0 + t; const bf16_t* row = P + tok * LDP + c0; const bf16_t* lo = LO + tok * LDLO + c0;
            w.gq = *(const u32x2*)row; w.gk = *(const u32x2*)(row + 512); w.gv = *(const u32x2*)(row + 1024);
            w.rr = *(const u32x2*)(row + PC_RB); w.rk = *(const u32x2*)(row + PC_RB + 512); w.rv = *(const u32x2*)(row + PC_RB + 1024);
            w.le = *(const u32x2*)lo; w.la = *(const u32x2*)(lo + 512);
            w.bl = BA[tok * 16 + h]; w.al = BA[tok * 16 + 8 + h];
        };
        PRaw cur, nxt;
        load(0, cur);
        __syncthreads();
        float G[4], Pprev[4];
#pragma unroll
        for (int i = 0; i < 4; ++i) { G[i] = 0.f; Pprev[i] = 1.f; }
        for (int t = 0; t < 32; ++t) {
            if (t + 1 < 32) load(t + 1, nxt);
            const size_t tok = (size_t)t0 + t; bf16_t* row = P + tok * LDP + c0;
            float gq[4], gk[4], gv[4]; unpack4f(cur.gq, gq); unpack4f(cur.gk, gk); unpack4f(cur.gv, gv);
            float q[4], k[4], v[4], sq = 0.f, sk = 0.f;
#pragma unroll
            for (int i = 0; i < 4; ++i) {
                q[i] = silu_(cw[0][0][i] * xw[0][0][i] + cw[1][0][i] * xw[1][0][i] + cw[2][0][i] * xw[2][0][i] + cw[3][0][i] * gq[i]);
                k[i] = silu_(cw[0][1][i] * xw[0][1][i] + cw[1][1][i] * xw[1][1][i] + cw[2][1][i] * xw[2][1][i] + cw[3][1][i] * gk[i]);
                v[i] = silu_(cw[0][2][i] * xw[0][2][i] + cw[1][2][i] * xw[1][2][i] + cw[2][2][i] * xw[2][2][i] + cw[3][2][i] * gv[i]);
                sq += q[i] * q[i]; sk += k[i] * k[i];
                xw[0][0][i] = xw[1][0][i]; xw[1][0][i] = xw[2][0][i]; xw[2][0][i] = gq[i];
                xw[0][1][i] = xw[1][1][i]; xw[1][1][i] = xw[2][1][i]; xw[2][1][i] = gk[i];
                xw[0][2][i] = xw[1][2][i]; xw[1][2][i] = xw[2][2][i]; xw[2][2][i] = gv[i];
            }
            const float rq = rsqrtf(red16f(sq) + 1e-6f) * 0.125f, rk_ = rsqrtf(red16f(sk) + 1e-6f);
#pragma unroll
            for (int i = 0; i < 4; ++i) { q[i] *= rq; k[i] *= rk_; }
            *(u32x2*)row = pack4f(q); *(u32x2*)(row + 512) = pack4f(k); *(u32x2*)(row + 1024) = pack4f(v);
            const float spx = cur.al + dtb;
            const float beta = sigm(cur.bl), alpha = __expf(nA * (spx > 15.f ? spx : __logf(1.f + __expf(spx))));
            if ((lane & 15) == 0) { BA[tok * 16 + h] = beta; BA[tok * 16 + 8 + h] = alpha; }
            float r[4], k2[4], v2[4], e[4], asg[4]; unpack4f(cur.rr, r); unpack4f(cur.rk, k2); unpack4f(cur.rv, v2); unpack4f(cur.le, e); unpack4f(cur.la, asg);
            float rm[4], km[4], vm[4], kx[4], skk = 0.f;
#pragma unroll
            for (int i = 0; i < 4; ++i) {
                rm[i] = r[i] + (pv[0][i] - r[i]) * mur[i]; km[i] = k2[i] + (pv[1][i] - k2[i]) * muk[i]; vm[i] = v2[i] + (pv[2][i] - v2[i]) * muv[i];
                pv[0][i] = r[i]; pv[1][i] = k2[i]; pv[2][i] = v2[i];
                kx[i] = km[i] * kkc[i]; skk += kx[i] * kx[i];
            }
            const float rkk = rsqrtf(red16f(skk) + 1e-6f);
            float o_r[4], o_k[4], o_a[4], o_b[4], pc[4];
#pragma unroll
            for (int i = 0; i < 4; ++i) {
                const float kkn = kx[i] * rkk, Pp = Pprev[i];
                G[i] += e[i]; const float Pc = __expf(-G[i]), iP = __expf(G[i]); Pprev[i] = Pc; pc[i] = Pc;
                const float kt = km[i] * (1.f + (asg[i] - 1.f) * kac[i]);
                o_r[i] = rm[i] * Pc; o_k[i] = kt * iP; o_a[i] = kkn * Pp; o_b[i] = kkn * asg[i] * iP;
            }
            *(u32x2*)(row + PC_RB) = pack4f(o_r); *(u32x2*)(row + PC_RB + 512) = pack4f(o_k); *(u32x2*)(row + PC_RB + 1024) = pack4f(vm); *(u32x2*)(row + PC_RB + 1536) = pack4f(o_a);
            *(u32x2*)(LO + tok * LDLO + c0) = pack4f(o_b);
            if (t == 31) *(f32x4*)(PEND + (tok >> 5) * 512 + c0) = (f32x4){pc[0], pc[1], pc[2], pc[3]};
            cur = nxt;
        }
        __syncthreads();
    }
}

struct Raw { u32x4 a, b, c, d, e; float s0, s1; f32x4 p0, p1; };
__device__ __forceinline__ void scan_phase(int wv, const Params& p, LAS unsigned char* lds, const bf16_t* P, const float* BA, const bf16_t* LO, const float* PEND, bf16_t* Y) {
    const int tid = opaque_tid(wv), wave = tid >> 6, lane = tid & 63;
    LAS float* fl = (LAS float*)lds;
    LAS float* yb = fl + 2 * INBUF;
    for (int item = blockIdx.x; item < 256; item += gridDim.x) {
        const int s = item >> 1, half = item & 1, br = s >> 6, b = (s >> 3) & 7, h = s & 7;
        const int ht = tid - 256, tt = (ht >> 3) & 31, cgp = ht & 7;
        Raw raw;
        auto load_raw = [&](int ch) {
            const size_t tok = (size_t)b * T + ch * TC + tt;
            if (br == 0) {
                const bf16_t* row = P + tok * LDP + h * 64 + 8 * cgp;
                raw.a = *(const u32x4*)row; raw.b = *(const u32x4*)(row + 512); raw.c = *(const u32x4*)(row + 1024);
                raw.s0 = BA[tok * 16 + h]; raw.s1 = BA[tok * 16 + 8 + h];
            } else {
                const bf16_t* row = P + tok * LDP + PC_RB + h * 64 + 8 * cgp;
                raw.a = *(const u32x4*)row; raw.b = *(const u32x4*)(row + 512); raw.c = *(const u32x4*)(row + 1024); raw.d = *(const u32x4*)(row + 1536);
                raw.e = *(const u32x4*)(LO + tok * LDLO + h * 64 + 8 * cgp);
                if (tt == 0) { const float* pe = PEND + ((size_t)b * (T / TC) + ch) * 512 + h * 64 + 8 * cgp; raw.p0 = *(const f32x4*)pe; raw.p1 = *(const f32x4*)(pe + 4); }
            }
        };
        auto compute = [&](int ch) {
            LAS float* bb = fl + (ch & 1) * INBUF;
            LAS float* buf = bb + tt * 64 + 8 * cgp;
            float R[8], V[8];
            if (br == 0) {
                float kh[8]; unpack8(raw.a, R); unpack8(raw.b, kh); unpack8(raw.c, V);
                *(LAS f32x4*)(buf + 3 * VEC) = (f32x4){kh[0], kh[1], kh[2], kh[3]}; *(LAS f32x4*)(buf + 3 * VEC + 4) = (f32x4){kh[4], kh[5], kh[6], kh[7]};
                if (cgp == 0) *(LAS f32x2*)(bb + SCOFF + 2 * tt) = (f32x2){raw.s1, raw.s0};
            } else {
                float K[8], A[8], Bv[8]; unpack8(raw.a, R); unpack8(raw.b, K); unpack8(raw.c, V); unpack8(raw.d, A); unpack8(raw.e, Bv);
                *(LAS f32x4*)(buf + 2 * VEC) = (f32x4){K[0], K[1], K[2], K[3]}; *(LAS f32x4*)(buf + 2 * VEC + 4) = (f32x4){K[4], K[5], K[6], K[7]};
                *(LAS f32x4*)(buf + 3 * VEC) = (f32x4){-A[0], -A[1], -A[2], -A[3]}; *(LAS f32x4*)(buf + 3 * VEC + 4) = (f32x4){-A[4], -A[5], -A[6], -A[7]};
                *(LAS f32x4*)(buf + 4 * VEC) = (f32x4){Bv[0], Bv[1], Bv[2], Bv[3]}; *(LAS f32x4*)(buf + 4 * VEC + 4) = (f32x4){Bv[4], Bv[5], Bv[6], Bv[7]};
                if (tt == 0) { *(LAS f32x4*)(bb + PEOFF + 8 * cgp) = raw.p0; *(LAS f32x4*)(bb + PEOFF + 8 * cgp + 4) = raw.p1; }
            }
            *(LAS f32x4*)(buf) = (f32x4){R[0], R[1], R[2], R[3]}; *(LAS f32x4*)(buf + 4) = (f32x4){R[4], R[5], R[6], R[7]};
            if ((cgp >> 2) == half) { LAS float* vb = bb + 5 * VEC + tt * 32 + 8 * (cgp & 3);
                *(LAS f32x4*)vb = (f32x4){V[0], V[1], V[2], V[3]}; *(LAS f32x4*)(vb + 4) = (f32x4){V[4], V[5], V[6], V[7]}; }
        };
        auto flush = [&](int ch) {
            const LAS float* ys = yb + (ch & 1) * (TC * 128) + tt * 128 + 16 * cgp;
            float y[4];
#pragma unroll
            for (int i = 0; i < 4; ++i) { const f32x4 v = *(const LAS f32x4*)(ys + 4 * i); y[i] = (v.x + v.y) + (v.z + v.w); }
            u32x2 o; o.x = pk2(y[0], y[1]); o.y = pk2(y[2], y[3]);
            *(u32x2*)(Y + ((size_t)b * T + ch * TC + tt) * 1024 + br * 512 + h * 64 + half * 32 + 4 * cgp) = o;
        };
        constexpr int NCH = T / TC;
        if (wave >= 4) { load_raw(0); compute(0); load_raw(1); }
        __syncthreads();
        f32x2 S[4];
#pragma unroll
        for (int i = 0; i < 4; ++i) S[i] = (f32x2){0.f, 0.f};
        const int cg = lane & 7, lrow = wave * 8 + (lane >> 3);
        for (int ch = 0; ch < NCH; ++ch) {
            if (wave < 4) {
                __builtin_amdgcn_s_setprio(3);
                const LAS float* buf = fl + (ch & 1) * INBUF; const LAS float* lb = buf + 8 * cg; const LAS float* vb = buf + 5 * VEC + lrow;
                LAS float* ys = yb + (ch & 1) * (TC * 128) + lrow * 4 + (cg >> 1);
                if (br) {
                    StepR sa_, sb_, sc_, sd_;
                    ld_stepR(sa_, lb, vb, 0); ld_stepR(sb_, lb, vb, 1);
#pragma unroll
                    for (int t = 0; t < TC; t += 4) {
                        ld_stepR(sc_, lb, vb, t + 2);
                        float y0 = do_stepR(S, sa_);
                        ld_stepR(sd_, lb, vb, t + 3);
                        float y1 = do_stepR(S, sb_);
                        if (t + 4 < TC) ld_stepR(sa_, lb, vb, t + 4);
                        float y2 = do_stepR(S, sc_);
                        if (t + 5 < TC) ld_stepR(sb_, lb, vb, t + 5);
                        float y3 = do_stepR(S, sd_);
                        y0 += dpp_f(y0, 0); y1 += dpp_f(y1, 0); y2 += dpp_f(y2, 0); y3 += dpp_f(y3, 0);
                        if ((cg & 1) == 0) { ys[t * 128] = y0; ys[(t + 1) * 128] = y1; ys[(t + 2) * 128] = y2; ys[(t + 3) * 128] = y3; }
                    }
#pragma unroll
                    for (int i = 0; i < 4; ++i) S[i] = S[i] * *(const LAS f32x2*)(buf + PEOFF + 8 * cg + 2 * i);
                } else {
                    const LAS float* sb = buf + SCOFF;
                    StepG sa_, sb_, sc_, sd_;
                    ld_stepG(sa_, lb, vb, sb, 0); ld_stepG(sb_, lb, vb, sb, 1);
#pragma unroll
                    for (int t = 0; t < TC; t += 4) {
                        ld_stepG(sc_, lb, vb, sb, t + 2);
                        float y0 = do_stepG(S, sa_);
                        ld_stepG(sd_, lb, vb, sb, t + 3);
                        float y1 = do_stepG(S, sb_);
                        if (t + 4 < TC) ld_stepG(sa_, lb, vb, sb, t + 4);
                        float y2 = do_stepG(S, sc_);
                        if (t + 5 < TC) ld_stepG(sb_, lb, vb, sb, t + 5);
                        float y3 = do_stepG(S, sd_);
                        y0 += dpp_f(y0, 0); y1 += dpp_f(y1, 0); y2 += dpp_f(y2, 0); y3 += dpp_f(y3, 0);
                        if ((cg & 1) == 0) { ys[t * 128] = y0; ys[(t + 1) * 128] = y1; ys[(t + 2) * 128] = y2; ys[(t + 3) * 128] = y3; }
                    }
                }
                __builtin_amdgcn_s_setprio(0);
            } else {
                if (ch + 1 < NCH) compute(ch + 1);
                if (ch + 2 < NCH) load_raw(ch + 2);
                if (ch > 0) flush(ch - 1);
            }
            __syncthreads();
        }
        if (wave >= 4) flush(NCH - 1);
        __syncthreads();
    }
    if (gridDim.x >= 256 ? blockIdx.x < 128 : true) xpose_range(wv, p, lds, XP_I0, XP_NIT, gridDim.x >= 256 ? (int)blockIdx.x : (int)blockIdx.x, gridDim.x >= 256 ? 128 : (int)gridDim.x);
}

struct PostRaw { u32x4 ya, z, yb, r, k, v, asg, g; };
__device__ __forceinline__ void post_phase(int wv, const Params& p, const bf16_t* P, const bf16_t* LO, bf16_t* Y) {
    const int tid_ = opaque_tid(wv); const int lane = tid_ & 63, gw = blockIdx.x * 8 + (tid_ >> 6), ngw = gridDim.x * 8;
    const int c0 = lane * 8;
    float onw[8], lw[8], lb[8], ka[8], rk[8];
#pragma unroll
    for (int i = 0; i < 8; ++i) { onw[i] = p.onorm_gdn[(c0 + i) & 63]; lw[i] = p.lnx_w[c0 + i]; lb[i] = p.lnx_b[c0 + i]; ka[i] = p.k_a[c0 + i]; rk[i] = p.r_k[c0 + i]; }
    auto load = [&](int tok, PostRaw& w) {
        const bf16_t* yr = Y + (size_t)tok * 1024 + c0; const bf16_t* pr = P + (size_t)tok * LDP + c0; const bf16_t* lo = LO + (size_t)tok * LDLO + c0;
        w.ya = *(const u32x4*)yr; w.yb = *(const u32x4*)(yr + 512); w.z = *(const u32x4*)(pr + PC_Z);
        w.r = *(const u32x4*)(pr + PC_RB); w.k = *(const u32x4*)(pr + PC_RB + 512); w.v = *(const u32x4*)(pr + PC_RB + 1024);
        w.asg = *(const u32x4*)(lo + 512); w.g = *(const u32x4*)(lo + 1024);
    };
    PostRaw cur, nxt;
    if (gw < NTOK) load(gw, cur);
    for (int tok = gw; tok < NTOK; tok += ngw) {
        const bool hn = tok + ngw < NTOK;
        if (hn) load(tok + ngw, nxt);
        bf16_t* yr = Y + (size_t)tok * 1024 + c0;
        {
            float o[8], z[8]; unpack8(cur.ya, o); unpack8(cur.z, z);
            float ss = 0.f;
#pragma unroll
            for (int i = 0; i < 8; ++i) ss += o[i] * o[i];
            ss = red8(ss);
            const float rs = rsqrtf(ss * (1.f / 64.f) + 1e-6f);
#pragma unroll
            for (int i = 0; i < 8; ++i) o[i] = o[i] * rs * onw[i] * silu_(z[i]);
            *(u32x4*)yr = pack8(o);
        }
        {
            float y[8], r[8], k[8], v[8], a[8], g[8];
            unpack8(cur.yb, y); unpack8(cur.r, r); unpack8(cur.k, k); unpack8(cur.v, v); unpack8(cur.asg, a); unpack8(cur.g, g);
            float sm = 0.f, sb = 0.f;
#pragma unroll
            for (int i = 0; i < 8; ++i) { sm += y[i]; sb += r[i] * k[i] * rk[i]; }
            const float mean = red8(sm) * (1.f / 64.f); const float bonus = red8(sb);
            float sv = 0.f;
#pragma unroll
            for (int i = 0; i < 8; ++i) { y[i] -= mean; sv += y[i] * y[i]; }
            const float rs = rsqrtf(red8(sv) * (1.f / 64.f) + 64e-5f);
#pragma unroll
            for (int i = 0; i < 8; ++i) y[i] = (y[i] * rs * lw[i] + lb[i] + bonus * v[i]) * g[i];
            *(u32x4*)(yr + 512) = pack8(y);
        }
        if (hn) cur = nxt;
    }
}

__device__ __forceinline__ void glu_fixup_phase(int wv, const Params& p, bf16_t* ACT, const bf16_t* BND) {
    const int total = 256 * 2 * (DFF / 8);
    for (int idx = blockIdx.x * 512 + opaque_tid(wv); idx < total; idx += gridDim.x * 512) {
        const int blk = idx / (2 * (DFF / 8)), rem = idx % (2 * (DFF / 8)), tk = rem / (DFF / 8), c0 = (rem % (DFF / 8)) * 8;
        if (((blk * 128) % T) == 0) continue;
        const bf16_t* prev = BND + (size_t)(blk - 1) * 4 * LDGU + c0;
        const bf16_t* cur = BND + (size_t)(blk * 4 + 2) * LDGU + c0;
        float g126[8], g127[8], g0[8], g1[8], uu[8];
        unpack8(*(const u32x4*)prev, g126); unpack8(*(const u32x4*)(prev + LDGU), g127);
        unpack8(*(const u32x4*)cur, g0); unpack8(*(const u32x4*)(cur + LDGU), g1);
        unpack8(*(const u32x4*)(cur + tk * LDGU + DFF), uu);
        float o[8];
#pragma unroll
        for (int j = 0; j < 8; ++j) {
            const float x0 = tk ? g1[j] : g0[j], x1 = tk ? g0[j] : g127[j], x2 = tk ? g127[j] : g126[j];
            const float cv = p.conv_ffn[2 * DFF + c0 + j] * x0 + p.conv_ffn[DFF + c0 + j] * x1 + p.conv_ffn[c0 + j] * x2;
            o[j] = silu_(cv) * uu[j];
        }
        *(u32x4*)(ACT + (size_t)(blk * 128 + tk) * DFF + c0) = pack8(o);
    }
}

__global__ void __launch_bounds__(512, 2) fwd_megakernel(Params p) {
    extern __shared__ __attribute__((aligned(16))) unsigned char shm[];
    cg::grid_group grid = cg::this_grid();
    const int wv = __builtin_amdgcn_readfirstlane((int)threadIdx.x >> 6);
    LAS unsigned char* lds = (LAS unsigned char*)shm;
    bf16_t* wtin = (bf16_t*)(p.ws + WS_WTIN); bf16_t* wtbr = (bf16_t*)(p.ws + WS_WTBR); bf16_t* wtout = (bf16_t*)(p.ws + WS_WTOUT);
    bf16_t* wtf1 = (bf16_t*)(p.ws + WS_WTF1); bf16_t* wtf2 = (bf16_t*)(p.ws + WS_WTF2); bf16_t* wtlo = (bf16_t*)(p.ws + WS_WTLO);
    float* mod = (float*)(p.ws + WS_MOD); float* BA = (float*)(p.ws + WS_BA);
    bf16_t* H = (bf16_t*)(p.ws + WS_H); bf16_t* P = (bf16_t*)(p.ws + WS_P);
    bf16_t* LO = (bf16_t*)p.out; bf16_t* ALO = LO + (size_t)NTOK * LDLO;
    float* PEND = (float*)(p.ws + WS_PEND);
    bf16_t* X1 = (bf16_t*)p.out;
    bf16_t* X2 = H;
    bf16_t* Y = H; bf16_t* ACT = P; bf16_t* BND = (bf16_t*)(p.ws + WS_BND); bf16_t* HALO = (bf16_t*)(p.ws + WS_HALO);
    pg8::StaticOrder S;
    volatile LAS unsigned* xst = (volatile LAS unsigned*)(lds + LDS_STAGE);
    if (opaque_tid(wv) == 0) { xst[0] = 0u; xst[1] = 0u; xst[2] = 0u; xst[3] = 0u; }
    __syncthreads();
    XcdBarrier xb; xb.bar = (unsigned*)(p.ws + WS_BAR); xb.x = xb_xcc_id(); xb.st = xst;
    if (opaque_tid(wv) == 0) (void)xb_add(&xb.bar[XB_XCNT(xb.x)], 1u);

    phase0(wv, p, lds);
    xcd_barrier(wv, xb);
    if (xb_ld(&xb.bar[XB_TMO]) != 0u) grid.sync();
    norm_mod_phase(wv, p.x, p.norm1_w, mod, 1024, 0, H);
    xcd_barrier(wv, xb);
    { pg8::Gemm g{H, wtin, NTOK, 6144, 1024, 1024, 1024, 1 << 30, 0}; S.init(g.M, g.N, gridDim.x, blockIdx.x); EpiP E{P, BA, HALO}; pg8::gemm_phase(wv, lds, g, S, E); }
    xcd_barrier(wv, xb);
    lora_phase(wv, p, lds, P, wtlo, LO);
    xcd_barrier(wv, xb);
    prep2_phase(wv, p, P, BA, HALO, LO, PEND);
    xcd_barrier(wv, xb);
    scan_phase(wv, p, lds, P, BA, LO, PEND, Y);
    xcd_barrier(wv, xb);
    post_phase(wv, p, P, LO, Y);
    xcd_barrier(wv, xb);
    { pg8::Gemm g{Y, wtbr, NTOK, 2048, 512, 1024, 512, 4, 512}; pg8::PairOrder PO; PO.so.init(NTOK, 1024, gridDim.x, blockIdx.x); EpiBr E{P}; pg8::gemm_phase(wv, lds, g, PO, E); }
    xcd_barrier(wv, xb);
    { pg8::Gemm g{P, wtout, NTOK, 1024, 1024, LDP, 1024, 1 << 30, 0}; S.init(g.M, g.N, gridDim.x, blockIdx.x); EpiX1 E{p.x, X1, mod + 2048}; pg8::gemm_phase(wv, lds, g, S, E); }
    xcd_barrier(wv, xb);
    norm_mod_bf16_phase(wv, X1, p.norm2_w, mod, 4096, 3072, H);
    xcd_barrier(wv, xb);
    { pg8::Gemm g{H, wtf1, NTOK, 5632, 1024, 1024, 1024, 1 << 30, 0}; S.init(g.M, g.N, gridDim.x, blockIdx.x); EpiGLU E{ACT, BND, p.conv_ffn}; pg8::gemm_phase(wv, lds, g, S, E); }
    xcd_barrier(wv, xb);
    glu_fixup_phase(wv, p, ACT, BND);
    xcd_barrier(wv, xb);
    { pg8::Gemm g{ACT, wtf2, NTOK, 1024, 2816, DFF, 2816, 1 << 30, 0}; S.init(g.M, g.N, gridDim.x, blockIdx.x); EpiX2 E{X1, X2, mod + 5120}; pg8::gemm_phase(wv, lds, g, S, E); }
    xcd_barrier(wv, xb);
    final_norm_phase(wv, X2, p.out, p.norm_f_w);
}

extern "C" void kernel_launch(void* const* d_in, const int* in_sizes, int n_in, void* d_out, int out_size, void* d_ws, size_t ws_size, hipStream_t stream) {
    static int grid_blocks = 0;
    if (grid_blocks == 0) {
        if (n_in != 29 || out_size != NTOK * D || ws_size < WS_END) { fprintf(stderr, "kernel_launch: unexpected shapes (n_in %d out %d ws %zu need %zu)\n", n_in, out_size, ws_size, (size_t)WS_END); grid_blocks = -1; return; }
        int dev = 0, cus = 0, per_cu = 0;
        hipGetDevice(&dev);
        hipDeviceGetAttribute(&cus, hipDeviceAttributeMultiprocessorCount, dev);
        hipFuncSetAttribute((const void*)fwd_megakernel, hipFuncAttributeMaxDynamicSharedMemorySize, LDS_BYTES);
        hipOccupancyMaxActiveBlocksPerMultiprocessor(&per_cu, (const void*)fwd_megakernel, 512, LDS_BYTES);
        if (per_cu < 1) { fprintf(stderr, "kernel_launch: occupancy query says 0 blocks/CU\n"); per_cu = 1; }
        if (per_cu > 1) per_cu = 1;
        grid_blocks = cus * per_cu;
    }
    if (grid_blocks < 0) return;
    (void)hipMemsetAsync((char*)d_ws + WS_BAR, 0, (size_t)XCD_BAR_WORDS_C * 4, stream);
    Params p{};
    const float** fp = (const float**)&p;
    for (int i = 0; i < 29; ++i) fp[i] = (const float*)d_in[i];
    p.out = (float*)d_out; p.ws = (unsigned char*)d_ws;
    void* args[] = {&p};
    hipError_t e = hipLaunchCooperativeKernel((const void*)fwd_megakernel, dim3(grid_blocks), dim3(512), args, LDS_BYTES, stream);
    if (e != hipSuccess) fprintf(stderr, "cooperative launch failed: %s (grid %d)\n", hipGetErrorString(e), grid_blocks);
}
```

```cpp
#include <hip/hip_runtime.h>
#include <hip/hip_cooperative_groups.h>
#include <cstdio>
namespace cg = cooperative_groups;

#define LAS __attribute__((address_space(3)))
typedef unsigned short bf16_t;
typedef short bf16x8 __attribute__((ext_vector_type(8)));
typedef float f32x4 __attribute__((ext_vector_type(4)));
typedef float f32x2 __attribute__((ext_vector_type(2)));
typedef unsigned u32x4 __attribute__((ext_vector_type(4)));
typedef unsigned u32x2 __attribute__((ext_vector_type(2)));

constexpr int NTOK = 32768, T = 4096, D = 1024;
constexpr int LDP = 6144;
constexpr int PC_Z = 1536, PC_RB = 2048, PC_LO = 3584, PC_GL = 4096;
constexpr int LDGU = 5632, DFF = 2816, LDLO = 1536, LDALO = 384;
constexpr int XCD_BAR_WORDS_C = 3456;
constexpr int LDS_STAGE = 131072;
constexpr int LDS_BYTES = LDS_STAGE + 16;

constexpr size_t WS_WTIN = 0;
constexpr size_t WS_WTBR = WS_WTIN + (size_t)6144 * 1024 * 2;
constexpr size_t WS_WTOUT = WS_WTBR + (size_t)2048 * 512 * 2;
constexpr size_t WS_WTF1 = WS_WTOUT + (size_t)1024 * 1024 * 2;
constexpr size_t WS_WTF2 = WS_WTF1 + (size_t)5632 * 1024 * 2;
constexpr size_t WS_WTLO = WS_WTF2 + (size_t)1024 * 2816 * 2;
constexpr size_t WS_MOD = WS_WTLO + (size_t)1536 * 384 * 2;
constexpr size_t WS_BA = WS_MOD + (size_t)8 * 6144 * 4;
constexpr size_t WS_H = WS_BA + (size_t)NTOK * 16 * 4;
constexpr size_t WS_P = WS_H + (size_t)NTOK * 1024 * 2;
constexpr size_t WS_HALO = WS_P + (size_t)NTOK * LDP * 2;
constexpr size_t WS_BAR = WS_HALO + (size_t)256 * 3 * 3072 * 2;
constexpr size_t WS_PEND = WS_BAR + (size_t)XCD_BAR_WORDS_C * 4;
constexpr size_t WS_BND = WS_PEND + (size_t)(NTOK / 32) * 512 * 4;
constexpr size_t WS_END = WS_BND + (size_t)256 * 4 * 5632 * 2;

struct Params {
    const float *x, *c, *w_ada, *b_ada, *norm1_w, *w_in, *conv_gdn, *a_log, *dt_bias, *onorm_gdn, *w_branch_gdn, *mu_rwkv, *w0, *w2, *a0, *a2, *g2, *k_k, *k_a, *r_k,
        *lnx_w, *lnx_b, *w_branch_rwkv, *w_out, *norm2_w, *w_ffn_in, *conv_ffn, *w_ffn_out, *norm_f_w;
    float* out;
    unsigned char* ws;
};

typedef __bf16 bf16v2_t __attribute__((ext_vector_type(2)));
__device__ __forceinline__ unsigned pk2(float lo, float hi) { const bf16v2_t t = __builtin_convertvector((f32x2){lo, hi}, bf16v2_t); return __builtin_bit_cast(unsigned, t); }
__device__ __forceinline__ float bf2f(bf16_t b) { return __uint_as_float(((unsigned)b) << 16); }
__device__ __forceinline__ bf16_t f2bf(float f) { return (bf16_t)(pk2(f, 0.f) & 0xffffu); }
__device__ __forceinline__ float lo_bf(unsigned u) { return __uint_as_float(u << 16); }
__device__ __forceinline__ float hi_bf(unsigned u) { return __uint_as_float(u & 0xffff0000u); }
__device__ __forceinline__ float sigm(float x) { return __builtin_amdgcn_rcpf(1.f + __expf(-x)); }
__device__ __forceinline__ float silu_(float x) { return x * __builtin_amdgcn_rcpf(1.f + __expf(-x)); }
__device__ __forceinline__ float softplus_(float x) { return x > 20.f ? x : log1pf(expf(x)); }
__device__ __forceinline__ float wave_sum(float v) {
#pragma unroll
    for (int o = 1; o < 64; o <<= 1) v += __shfl_xor(v, o);
    return v;
}
__device__ __forceinline__ float dpp_f(float x, const int ctrl_sel) {
    int xi = __builtin_bit_cast(int, x), r;
    if (ctrl_sel == 0) r = __builtin_amdgcn_update_dpp(0, xi, 0xB1, 0xF, 0xF, true);
    else if (ctrl_sel == 1) r = __builtin_amdgcn_update_dpp(0, xi, 0x4E, 0xF, 0xF, true);
    else r = __builtin_amdgcn_update_dpp(0, xi, 0x141, 0xF, 0xF, true);
    return __builtin_bit_cast(float, r);
}
__device__ __forceinline__ float dpp_rm(float x) { int xi = __builtin_bit_cast(int, x); return __builtin_bit_cast(float, __builtin_amdgcn_update_dpp(0, xi, 0x140, 0xF, 0xF, true)); }
__device__ __forceinline__ float wsum(float x) {
    x += dpp_f(x, 0); x += dpp_f(x, 1); x += dpp_f(x, 2); x += dpp_rm(x);
    const int xi = __builtin_bit_cast(int, x);
    const float a = __builtin_bit_cast(float, __builtin_amdgcn_readlane(xi, 0)), b = __builtin_bit_cast(float, __builtin_amdgcn_readlane(xi, 16));
    const float c = __builtin_bit_cast(float, __builtin_amdgcn_readlane(xi, 32)), d = __builtin_bit_cast(float, __builtin_amdgcn_readlane(xi, 48));
    return (a + b) + (c + d);
}
__device__ __forceinline__ float red8(float x) { x += dpp_f(x, 0); x += dpp_f(x, 1); x += dpp_f(x, 2); return x; }

__device__ __forceinline__ void unpack8(const u32x4 u, float (&v)[8]) {
    v[0] = lo_bf(u.x); v[1] = hi_bf(u.x); v[2] = lo_bf(u.y); v[3] = hi_bf(u.y); v[4] = lo_bf(u.z); v[5] = hi_bf(u.z); v[6] = lo_bf(u.w); v[7] = hi_bf(u.w);
}
__device__ __forceinline__ u32x4 pack8(const float (&v)[8]) { u32x4 o; o.x = pk2(v[0], v[1]); o.y = pk2(v[2], v[3]); o.z = pk2(v[4], v[5]); o.w = pk2(v[6], v[7]); return o; }
__device__ __forceinline__ int opaque_tid(int wv) { int t; asm volatile("v_mbcnt_lo_u32_b32 %0, -1, 0\n\tv_mbcnt_hi_u32_b32 %0, -1, %0" : "=v"(t)); return wv * 64 + t; }
__device__ __forceinline__ int opaque_bid() { int t = blockIdx.x; asm volatile("" : "+s"(t)); return t; }

#define XB_TMO      128
#define XB_XCNT(j)  (256  + 64 * (j))
#define XB_XSUB(j)  (1280 + 64 * (j))
#define XB_XGEN(j)  (2304 + 64 * (j))
#define XB_TOP      3328
#define XB_TOPGEN   3392
#define XCD_BAR_WORDS 3456
#define XB_SPIN_CAP (1u << 18)
__device__ __forceinline__ unsigned xb_ld(unsigned* p)              { return __hip_atomic_load(p, __ATOMIC_RELAXED, __HIP_MEMORY_SCOPE_AGENT); }
__device__ __forceinline__ unsigned xb_add(unsigned* p, unsigned v) { return __hip_atomic_fetch_add(p, v, __ATOMIC_RELAXED, __HIP_MEMORY_SCOPE_AGENT); }
__device__ __forceinline__ unsigned xb_xcc_id() { return (unsigned)__builtin_amdgcn_s_getreg((3 << 11) | 20) & 0xFu; }
#define XB_SPIN(cond, bar) do { unsigned _sp = 0; while (cond) { __builtin_amdgcn_s_sleep(1); \
    if ((++_sp & 255u) == 0u) { if (xb_ld(&(bar)[XB_TMO])) break; if (_sp > XB_SPIN_CAP) { atomicAdd(&(bar)[XB_TMO], 1u); break; } } } } while (0)
struct XcdBarrier { unsigned* bar; unsigned x; volatile LAS unsigned* st; };
__device__ __forceinline__ void xcd_barrier_complete(unsigned* bar, unsigned x, unsigned& nloc, unsigned& nx) {
    const unsigned G = gridDim.x * gridDim.y * gridDim.z;
    unsigned sum, cnt, mine, sp = 0u;
    for (;;) {
        sum = 0u; cnt = 0u; mine = 0u;
#pragma unroll
        for (unsigned j = 0; j < 16; ++j) { const unsigned c = xb_ld(&bar[XB_XCNT(j)]); sum += c; cnt += (c > 0u) ? 1u : 0u; mine = (j == x) ? c : mine; }
        if (sum == G) break;
        __builtin_amdgcn_s_sleep(1);
        if ((++sp & 255u) == 0u) { if (xb_ld(&bar[XB_TMO])) break; if (sp > XB_SPIN_CAP) { atomicAdd(&bar[XB_TMO], 1u); break; } }
    }
    nloc = mine > 0u ? mine : 1u; nx = cnt > 0u ? cnt : 1u;
}
__device__ __forceinline__ void xcd_barrier(int wv, const XcdBarrier& b) {
    asm volatile("s_waitcnt vmcnt(0)" ::: "memory");
    __syncthreads();
    if (opaque_tid(wv) == 0) {
        unsigned* bar = b.bar;
        __builtin_amdgcn_s_waitcnt(0);
        unsigned nloc = b.st[0], nx = b.st[1];
        if (nloc == 0u) { xcd_barrier_complete(bar, b.x, nloc, nx); b.st[0] = nloc; b.st[1] = nx; }
        const unsigned old = xb_add(&bar[XB_XSUB(b.x)], 1u);
        const unsigned gen = old / nloc;
        if (old + 1u == (gen + 1u) * nloc) {
            __builtin_amdgcn_fence(__ATOMIC_RELEASE, "agent");
            asm volatile("s_waitcnt vmcnt(0)" ::: "memory");
            const unsigned og = xb_add(&bar[XB_TOP], 1u);
            const unsigned tg = og / nx;
            if (og + 1u == (tg + 1u) * nx) xb_add(&bar[XB_TOPGEN], 1u);
            else XB_SPIN(xb_ld(&bar[XB_TOPGEN]) == tg, bar);
            __builtin_amdgcn_fence(__ATOMIC_ACQUIRE, "agent");
            xb_add(&bar[XB_XGEN(b.x)], 1u);
            asm volatile("s_waitcnt vmcnt(0)" ::: "memory");
        } else {
            XB_SPIN(xb_ld(&bar[XB_XGEN(b.x)]) == gen, bar);
            __builtin_amdgcn_fence(__ATOMIC_ACQUIRE, "agent");
            asm volatile("s_waitcnt vmcnt(0)" ::: "memory");
        }
    }
    __syncthreads();
}
namespace pg8 {
constexpr int BM = 256, BK = 64, HALF = 128, HTB = HALF * BK * 2, NXCD = 8, WGM = 8;
__device__ __forceinline__ int lds_byte(int r, int c) { const int st = (r >> 4) * 2 + (c >> 5), rr = r & 15, cc = c & 31, ob = rr * 64 + cc * 2; return st * 1024 + (ob ^ (((ob >> 9) & 1) << 5)); }
__device__ __forceinline__ void stage_rc(int b, int& R, int& C) { const int st = b / 1024, sb = b % 1024, swz = sb ^ (((sb >> 9) & 1) << 5); R = (st >> 1) * 16 + swz / 64; C = (st & 1) * 32 + (swz % 64) / 2; }
__device__ __forceinline__ int perm32(int rho) { const int n = rho >> 4, i = rho & 15; return 8 * (i >> 2) + 4 * n + (i & 3); }
struct Unit { int pm, pn; };
struct Gemm { const bf16_t* A; const bf16_t* Bt; int M, N, K, lda, ldb, asplit, aoff2; };
struct StaticOrder {
    int nM, nN, nwg, G, c;
    __device__ void init(int M, int N, int G_, int c_) { nM = M / BM; nN = N / BM; nwg = nM * nN; G = G_; c = c_; }
    __device__ bool next(int i, Unit& u) const {
        const long L = (long)i * G + c; if (L >= nwg) return false;
        int wgid = (int)L; { const int q = nwg / NXCD, r = nwg % NXCD, xcd = wgid % NXCD, off = wgid / NXCD; wgid = (xcd < r ? xcd * (q + 1) : r * (q + 1) + (xcd - r) * q) + off; }
        const int nig = WGM * nN, gid = wgid / nig, fm = gid * WGM, gsz = (nM - fm) < WGM ? (nM - fm) : WGM;
        u.pm = fm + ((wgid % nig) % gsz); u.pn = (wgid % nig) / gsz; return true;
    }
};

struct PairOrder {
    StaticOrder so;
    __device__ bool next(int i, Unit& u) const { Unit t; if (!so.next(i >> 1, t)) return false; u.pm = t.pm; u.pn = t.pn + 4 * (i & 1); return true; }
};
template <class Epi, class Sched>
__device__ __forceinline__ void gemm_phase(int wv, LAS unsigned char* lds, const Gemm g, const Sched& S, const Epi& E) {
    const int tid = opaque_tid(wv), wid = __builtin_amdgcn_readfirstlane(tid >> 6), lane = tid & 63, wr = wid >> 2, wc = wid & 3, fr = lane & 15, fq = lane >> 4;
    const int K = g.K, nt = K / BK;
    unsigned voffA[2], voffB[2];
#pragma unroll
    for (int i = 0; i < 2; ++i) { int R, C; stage_rc(tid * 16 + i * 8192, R, C); const int Rb = Epi::PERM ? ((R & ~31) + perm32(R & 31)) : R;
        const int Ra = Epi::ROWPERM ? (8 * ((R & 15) + 16 * (R >> 6)) + ((R >> 4) & 3)) : R;
        voffA[i] = (unsigned)(Ra * g.lda + C) * 2u; voffB[i] = (unsigned)(Rb * g.ldb + C) * 2u; }
    const size_t kstep = (size_t)(BK * 2);
    const size_t hstepA = Epi::ROWPERM ? (size_t)4 * g.lda * 2 : (size_t)HALF * g.lda * 2, hstepB = (size_t)HALF * g.ldb * 2;
    const size_t tstepA = (size_t)2 * HALF * g.lda * 2, tstepB = 2 * hstepB;
    const unsigned ldsw = (unsigned)wid * 1024u;
    const int aoff = lds_byte(wr * 64 + fr, fq * 8), boff = lds_byte(wc * 32 + fr, fq * 8);
#define PG8_SA(b, h) (((b) * 2 + (h)) * HTB)
#define PG8_SB(b, h) ((4 + (b) * 2 + (h)) * HTB)
#define PG8_STAGE(bufoff, gbase, voff) do { _Pragma("unroll") for (int _i = 0; _i < 2; ++_i) \
        __builtin_amdgcn_global_load_lds((const unsigned*)((const char*)(gbase) + (voff)[_i]), (LAS unsigned*)(lds + (bufoff) + ldsw + _i * 8192), 16, 0, 0); } while (0)
#define PG8_LDA(dst, b, h) do { _Pragma("unroll") for (int m = 0; m < 4; ++m) _Pragma("unroll") for (int k = 0; k < 2; ++k) dst[m][k] = *(const LAS bf16x8*)(lds + PG8_SA(b, h) + aoff + m * 2048 + k * 1024); } while (0)
#define PG8_LDB(dst, b, h) do { _Pragma("unroll") for (int n = 0; n < 2; ++n) _Pragma("unroll") for (int k = 0; k < 2; ++k) dst[n][k] = *(const LAS bf16x8*)(lds + PG8_SB(b, h) + boff + n * 2048 + k * 1024); } while (0)
#define PG8_MMA(ai, bj, At, Bt) do { __builtin_amdgcn_s_setprio(1); _Pragma("unroll") for (int m = 0; m < 4; ++m) _Pragma("unroll") for (int n = 0; n < 2; ++n) _Pragma("unroll") for (int k = 0; k < 2; ++k) \
        acc[ai][bj][m][n] = __builtin_amdgcn_mfma_f32_16x16x32_bf16(Bt[n][k], At[m][k], acc[ai][bj][m][n], 0, 0, 0); __builtin_amdgcn_s_setprio(0); } while (0)
#define PG8_WAIT_V(n) asm volatile("s_waitcnt vmcnt(" #n ")" ::: "memory")
#define PG8_WAIT_L(n) asm volatile("s_waitcnt lgkmcnt(" #n ")" ::: "memory")
#define PG8_BAR __builtin_amdgcn_s_barrier()
#define PG8_SCHED __builtin_amdgcn_sched_barrier(0)
#define PG8_APTR(u) ((const char*)g.A + (size_t)(u).pm * tstepA + ((u).pn >= g.asplit ? (size_t)g.aoff2 * 2 : (size_t)0))
    Unit cur, nxt; int ui = 0;
    if (!S.next(0, cur)) return;
    f32x4 acc[2][2][4][2];
#pragma unroll
    for (int a = 0; a < 2; ++a)
#pragma unroll
        for (int b = 0; b < 2; ++b)
#pragma unroll
            for (int m = 0; m < 4; ++m)
#pragma unroll
                for (int n = 0; n < 2; ++n) acc[a][b][m][n] = (f32x4){0.f, 0.f, 0.f, 0.f};
    bf16x8 At[4][2], B0[2][2], B1[2][2];
    const char* cA = PG8_APTR(cur); const char* cB = (const char*)g.Bt + (size_t)cur.pn * tstepB;
    PG8_STAGE(PG8_SB(0, 0), cB, voffB); PG8_STAGE(PG8_SA(0, 0), cA, voffA); PG8_STAGE(PG8_SB(0, 1), cB + hstepB, voffB); PG8_STAGE(PG8_SA(0, 1), cA + hstepA, voffA);
    if (wr == 1) PG8_BAR;
    PG8_WAIT_V(4); PG8_BAR;
    PG8_STAGE(PG8_SB(1, 0), cB + kstep, voffB); PG8_STAGE(PG8_SA(1, 0), cA + kstep, voffA); PG8_STAGE(PG8_SB(1, 1), cB + hstepB + kstep, voffB);
    PG8_WAIT_V(6); PG8_BAR;
    for (;;) {
        const bool has_next = S.next(ui + 1, nxt);
        const char* nA = has_next ? PG8_APTR(nxt) : cA; const char* nB = has_next ? (const char*)g.Bt + (size_t)nxt.pn * tstepB : cB;
        for (int t = 0; t < nt; t += 2) {
            const bool last = (t == nt - 2);
            const char* a1 = cA + (size_t)(t + 1) * kstep;
            const char* a2 = last ? nA : cA + (size_t)(t + 2) * kstep; const char* b2 = last ? nB : cB + (size_t)(t + 2) * kstep;
            const char* a3 = a2 + kstep; const char* b3 = b2 + kstep;
            PG8_LDB(B0, 0, 0); PG8_SCHED; PG8_LDA(At, 0, 0); PG8_STAGE(PG8_SA(1, 1), a1 + hstepA, voffA);
            PG8_WAIT_L(8); PG8_BAR; PG8_WAIT_L(0); PG8_MMA(0, 0, At, B0); PG8_BAR; PG8_SCHED;
            PG8_LDB(B1, 0, 1); PG8_STAGE(PG8_SB(0, 0), b2, voffB);
            PG8_BAR; PG8_WAIT_L(0); PG8_MMA(0, 1, At, B1); PG8_BAR;
            PG8_LDA(At, 0, 1); PG8_STAGE(PG8_SA(0, 0), a2, voffA);
            PG8_BAR; PG8_WAIT_L(0); PG8_MMA(1, 0, At, B0); PG8_BAR; PG8_SCHED;
            PG8_STAGE(PG8_SB(0, 1), b2 + hstepB, voffB);
            PG8_WAIT_V(6); PG8_BAR; PG8_MMA(1, 1, At, B1); PG8_BAR;
            PG8_LDB(B0, 1, 0); PG8_SCHED; PG8_LDA(At, 1, 0); PG8_STAGE(PG8_SA(0, 1), a2 + hstepA, voffA);
            PG8_WAIT_L(8); PG8_BAR; PG8_WAIT_L(0); PG8_MMA(0, 0, At, B0); PG8_BAR; PG8_SCHED;
            PG8_LDB(B1, 1, 1); PG8_STAGE(PG8_SB(1, 0), b3, voffB);
            PG8_BAR; PG8_WAIT_L(0); PG8_MMA(0, 1, At, B1); PG8_BAR;
            PG8_LDA(At, 1, 1); PG8_STAGE(PG8_SA(1, 0), a3, voffA);
            PG8_BAR; PG8_WAIT_L(0); PG8_MMA(1, 0, At, B0); PG8_BAR; PG8_SCHED;
            PG8_STAGE(PG8_SB(1, 1), b3 + hstepB, voffB);
            PG8_WAIT_V(6); PG8_BAR; PG8_MMA(1, 1, At, B1); PG8_BAR;
        }
        E(acc, cur, wr, wc, fr, fq);
        if (!has_next) break;
#pragma unroll
        for (int a = 0; a < 2; ++a)
#pragma unroll
            for (int b = 0; b < 2; ++b)
#pragma unroll
                for (int m = 0; m < 4; ++m)
#pragma unroll
                    for (int n = 0; n < 2; ++n) acc[a][b][m][n] = (f32x4){0.f, 0.f, 0.f, 0.f};
        cur = nxt; cA = nA; cB = nB; ++ui;
    }
    PG8_WAIT_V(0);
    if (wr == 0) PG8_BAR;
    PG8_BAR;
#undef PG8_SA
#undef PG8_SB
#undef PG8_STAGE
#undef PG8_LDA
#undef PG8_LDB
#undef PG8_MMA
#undef PG8_WAIT_V
#undef PG8_WAIT_L
#undef PG8_BAR
#undef PG8_SCHED
#undef PG8_APTR
}
}
using pg8::Unit;

struct EpiP {
    static constexpr bool PERM = true, ROWPERM = false;
    bf16_t* P; float* BA; bf16_t* HALO;
    __device__ __forceinline__ void operator()(const f32x4 (&acc)[2][2][4][2], const Unit& u, int wr, int wc, int fr, int fq) const {
        const int row0 = u.pm * 256 + wr * 64 + fr, col0 = u.pn * 256 + wc * 32 + 8 * fq;
        const bool gate = u.pn >= 16;
        const bool halo = (u.pn < 6 || (u.pn >= 8 && u.pn < 14)) && wr == 1 && fr >= 13;
        const int hcol = u.pn < 6 ? col0 : col0 - 512;
#pragma unroll
        for (int ai = 0; ai < 2; ++ai)
#pragma unroll
            for (int m = 0; m < 4; ++m) {
                const int row = row0 + ai * 128 + m * 16; bf16_t* rowp = P + (size_t)row * LDP + col0;
#pragma unroll
                for (int bj = 0; bj < 2; ++bj) {
                    f32x4 v0 = acc[ai][bj][m][0], v1 = acc[ai][bj][m][1];
                    if (u.pn == 15 && bj == 0 && wc == 1 && fq < 2) { float* d = BA + (size_t)row * 16 + fq * 8; *(f32x4*)d = v0; *(f32x4*)(d + 4) = v1; }
                    if (gate) {
#pragma unroll
                        for (int j = 0; j < 4; ++j) { v0[j] = sigm(v0[j]); v1[j] = sigm(v1[j]); }
                    }
                    u32x4 o; o.x = pk2(v0[0], v0[1]); o.y = pk2(v0[2], v0[3]); o.z = pk2(v1[0], v1[1]); o.w = pk2(v1[2], v1[3]);
                    *(u32x4*)(rowp + bj * 128) = o;
                    if (halo && m == 3) *(u32x4*)(HALO + ((size_t)((2 * u.pm + ai) * 3 + (fr - 13))) * 3072 + hcol + bj * 128) = o;
                }
            }
    }
};
struct EpiStore {
    static constexpr bool PERM = true, ROWPERM = false;
    bf16_t* O; int ldc;
    __device__ __forceinline__ void operator()(const f32x4 (&acc)[2][2][4][2], const Unit& u, int wr, int wc, int fr, int fq) const {
        const int row0 = u.pm * 256 + wr * 64 + fr, col0 = u.pn * 256 + wc * 32 + 8 * fq;
#pragma unroll
        for (int ai = 0; ai < 2; ++ai)
#pragma unroll
            for (int m = 0; m < 4; ++m) {
                bf16_t* rowp = O + (size_t)(row0 + ai * 128 + m * 16) * ldc + col0;
#pragma unroll
                for (int bj = 0; bj < 2; ++bj) {
                    const f32x4 v0 = acc[ai][bj][m][0], v1 = acc[ai][bj][m][1];
                    u32x4 o; o.x = pk2(v0[0], v0[1]); o.y = pk2(v0[2], v0[3]); o.z = pk2(v1[0], v1[1]); o.w = pk2(v1[2], v1[3]);
                    *(u32x4*)(rowp + bj * 128) = o;
                }
            }
    }
};
struct EpiLo {
    static constexpr bool PERM = true, ROWPERM = false;
    bf16_t* O; const float* w0; const float* a0;
    __device__ __forceinline__ void operator()(const f32x4 (&acc)[2][2][4][2], const Unit& u, int wr, int wc, int fr, int fq) const {
        const int row0 = u.pm * 256 + wr * 64 + fr, col0 = u.pn * 256 + wc * 32 + 8 * fq;
        const int region = u.pn >> 1;
        const float* bsrc = region == 0 ? w0 : a0;
        const float sc = region == 0 ? 0.60653066f : 1.f;
#pragma unroll
        for (int bj = 0; bj < 2; ++bj) {
            const int c = col0 + bj * 128;
            f32x4 b0 = (f32x4){0.f, 0.f, 0.f, 0.f}, b1 = b0;
            if (region < 2) { b0 = *(const f32x4*)(bsrc + (c & 511)); b1 = *(const f32x4*)(bsrc + (c & 511) + 4); }
#pragma unroll
            for (int ai = 0; ai < 2; ++ai)
#pragma unroll
                for (int m = 0; m < 4; ++m) {
                    bf16_t* rowp = O + (size_t)(row0 + ai * 128 + m * 16) * LDLO + c;
                    f32x4 v0 = acc[ai][bj][m][0] + b0, v1 = acc[ai][bj][m][1] + b1;
                    if (region < 2) {
#pragma unroll
                        for (int j = 0; j < 4; ++j) { v0[j] = sc * sigm(v0[j]); v1[j] = sc * sigm(v1[j]); }
                    }
                    u32x4 o; o.x = pk2(v0[0], v0[1]); o.y = pk2(v0[2], v0[3]); o.z = pk2(v1[0], v1[1]); o.w = pk2(v1[2], v1[3]);
                    *(u32x4*)rowp = o;
                }
        }
    }
};
struct EpiBr {
    static constexpr bool PERM = true, ROWPERM = false;
    bf16_t* P;
    __device__ __forceinline__ void operator()(const f32x4 (&acc)[2][2][4][2], const Unit& u, int wr, int wc, int fr, int fq) const {
        const int row0 = u.pm * 256 + wr * 64 + fr, col0 = (u.pn & 3) * 256 + wc * 32 + 8 * fq;
        const bool second = u.pn >= 4;
        const int gcol = PC_GL + (second ? 1024 : 0);
#pragma unroll
        for (int bj = 0; bj < 2; ++bj) {
#pragma unroll
            for (int ai = 0; ai < 2; ++ai) {
                u32x4 gv[4], pv[4];
#pragma unroll
                for (int m = 0; m < 4; ++m) { const bf16_t* rowp = P + (size_t)(row0 + ai * 128 + m * 16) * LDP + col0 + bj * 128;
                    gv[m] = *(const u32x4*)(rowp + gcol);
                    pv[m] = second ? *(const u32x4*)rowp : (u32x4){0u, 0u, 0u, 0u}; }
#pragma unroll
                for (int m = 0; m < 4; ++m) {
                    bf16_t* rowp = P + (size_t)(row0 + ai * 128 + m * 16) * LDP + col0 + bj * 128;
                    const u32x4 g = gv[m], q = pv[m];
                    const f32x4 v0 = acc[ai][bj][m][0], v1 = acc[ai][bj][m][1];
                    float o[8];
                    o[0] = v0[0] * lo_bf(g.x) + lo_bf(q.x); o[1] = v0[1] * hi_bf(g.x) + hi_bf(q.x); o[2] = v0[2] * lo_bf(g.y) + lo_bf(q.y); o[3] = v0[3] * hi_bf(g.y) + hi_bf(q.y);
                    o[4] = v1[0] * lo_bf(g.z) + lo_bf(q.z); o[5] = v1[1] * hi_bf(g.z) + hi_bf(q.z); o[6] = v1[2] * lo_bf(g.w) + lo_bf(q.w); o[7] = v1[3] * hi_bf(g.w) + hi_bf(q.w);
                    *(u32x4*)rowp = pack8(o);
                }
            }
        }
    }
};
struct EpiGLU {
    static constexpr bool PERM = true, ROWPERM = true;
    bf16_t* ACT; bf16_t* BND; const float* cw;
    __device__ __forceinline__ void operator()(const f32x4 (&acc)[2][2][4][2], const Unit& u, int wr, int wc, int fr, int fq) const {
        const int tb = u.pm * 256 + 8 * (fr + 16 * wr);
        const int c0 = u.pn * 128 + wc * 32 + 8 * fq;
        const int blk = 2 * u.pm + wr;
        u32x2 ap[8][2];
        u32x2 gq[4][2];
#pragma unroll
        for (int n = 0; n < 2; ++n) {
            const f32x4 w0 = *(const f32x4*)(cw + c0 + 4 * n), w1 = *(const f32x4*)(cw + DFF + c0 + 4 * n), w2 = *(const f32x4*)(cw + 2 * DFF + c0 + 4 * n);
            f32x4 gm1, gm2;
#pragma unroll
            for (int j = 0; j < 4; ++j) {
                const float s1 = __shfl_up(acc[1][0][3][n][j], 1, 16), s2 = __shfl_up(acc[1][0][2][n][j], 1, 16);
                gm1[j] = fr == 0 ? 0.f : s1; gm2[j] = fr == 0 ? 0.f : s2;
            }
#pragma unroll
            for (int k = 0; k < 8; ++k) {
                const f32x4 g = acc[k >> 2][0][k & 3][n], up = acc[k >> 2][1][k & 3][n];
                const f32x4 x1 = k >= 1 ? acc[(k - 1 < 0 ? 0 : k - 1) >> 2][0][(k - 1 < 0 ? 0 : k - 1) & 3][n] : gm1;
                const f32x4 x2 = k >= 2 ? acc[(k - 2 < 0 ? 0 : k - 2) >> 2][0][(k - 2 < 0 ? 0 : k - 2) & 3][n] : (k == 1 ? gm1 : gm2);
                float o[4];
#pragma unroll
                for (int j = 0; j < 4; ++j) { const float cv = w2[j] * g[j] + w1[j] * x1[j] + w0[j] * x2[j]; o[j] = silu_(cv) * up[j]; }
                ap[k][n].x = pk2(o[0], o[1]); ap[k][n].y = pk2(o[2], o[3]);
            }
            gq[0][n].x = pk2(acc[1][0][2][n][0], acc[1][0][2][n][1]); gq[0][n].y = pk2(acc[1][0][2][n][2], acc[1][0][2][n][3]);
            gq[1][n].x = pk2(acc[1][0][3][n][0], acc[1][0][3][n][1]); gq[1][n].y = pk2(acc[1][0][3][n][2], acc[1][0][3][n][3]);
            gq[2][n].x = pk2(acc[0][0][0][n][0], acc[0][0][0][n][1]); gq[2][n].y = pk2(acc[0][0][0][n][2], acc[0][0][0][n][3]);
            gq[3][n].x = pk2(acc[0][0][1][n][0], acc[0][0][1][n][1]); gq[3][n].y = pk2(acc[0][0][1][n][2], acc[0][0][1][n][3]);
        }
#pragma unroll
        for (int k = 0; k < 8; ++k) { u32x4 o; o.x = ap[k][0].x; o.y = ap[k][0].y; o.z = ap[k][1].x; o.w = ap[k][1].y;
            *(u32x4*)(ACT + (size_t)(tb + k) * DFF + c0) = o; }
        bf16_t* bp = BND + (size_t)blk * 4 * LDGU + c0;
        if (fr == 15) {
            u32x4 a; a.x = gq[0][0].x; a.y = gq[0][0].y; a.z = gq[0][1].x; a.w = gq[0][1].y; *(u32x4*)(bp) = a;
            u32x4 b; b.x = gq[1][0].x; b.y = gq[1][0].y; b.z = gq[1][1].x; b.w = gq[1][1].y; *(u32x4*)(bp + LDGU) = b;
        }
        if (fr == 0) {
            u32x4 a; a.x = gq[2][0].x; a.y = gq[2][0].y; a.z = gq[2][1].x; a.w = gq[2][1].y; *(u32x4*)(bp + 2 * LDGU) = a;
            u32x4 b; b.x = gq[3][0].x; b.y = gq[3][0].y; b.z = gq[3][1].x; b.w = gq[3][1].y; *(u32x4*)(bp + 3 * LDGU) = b;
#pragma unroll
            for (int k = 0; k < 2; ++k) { u32x4 v; v.x = pk2(acc[0][1][k][0][0], acc[0][1][k][0][1]); v.y = pk2(acc[0][1][k][0][2], acc[0][1][k][0][3]);
                v.z = pk2(acc[0][1][k][1][0], acc[0][1][k][1][1]); v.w = pk2(acc[0][1][k][1][2], acc[0][1][k][1][3]);
                *(u32x4*)(bp + (2 + k) * LDGU + DFF) = v; }
        }
    }
};
struct EpiX1 {
    static constexpr bool PERM = true, ROWPERM = false;
    const float* x; bf16_t* X1; const float* gate;
    __device__ __forceinline__ void operator()(const f32x4 (&acc)[2][2][4][2], const Unit& u, int wr, int wc, int fr, int fq) const {
        const int row0 = u.pm * 256 + wr * 64 + fr, col0 = u.pn * 256 + wc * 32 + 8 * fq;
        const float* gp = gate + (size_t)((u.pm * 256) / T) * 6144 + col0;
#pragma unroll
        for (int bj = 0; bj < 2; ++bj) {
            const f32x4 g0 = *(const f32x4*)(gp + bj * 128), g1 = *(const f32x4*)(gp + bj * 128 + 4);
#pragma unroll
            for (int ai = 0; ai < 2; ++ai) {
                f32x4 r0[4], r1[4];
#pragma unroll
                for (int m = 0; m < 4; ++m) { const size_t ro = (size_t)(row0 + ai * 128 + m * 16) * D + col0 + bj * 128; r0[m] = *(const f32x4*)(x + ro); r1[m] = *(const f32x4*)(x + ro + 4); }
#pragma unroll
                for (int m = 0; m < 4; ++m) {
                    const size_t ro = (size_t)(row0 + ai * 128 + m * 16) * D + col0 + bj * 128;
                    const f32x4 v0 = r0[m] + g0 * acc[ai][bj][m][0], v1 = r1[m] + g1 * acc[ai][bj][m][1];
                    u32x4 o; o.x = pk2(v0[0], v0[1]); o.y = pk2(v0[2], v0[3]); o.z = pk2(v1[0], v1[1]); o.w = pk2(v1[2], v1[3]);
                    *(u32x4*)(X1 + ro) = o;
                }
            }
        }
    }
};
struct EpiX2 {
    static constexpr bool PERM = true, ROWPERM = false;
    const bf16_t* X1; bf16_t* X2; const float* gate;
    __device__ __forceinline__ void operator()(const f32x4 (&acc)[2][2][4][2], const Unit& u, int wr, int wc, int fr, int fq) const {
        const int row0 = u.pm * 256 + wr * 64 + fr, col0 = u.pn * 256 + wc * 32 + 8 * fq;
        const float* gp = gate + (size_t)((u.pm * 256) / T) * 6144 + col0;
#pragma unroll
        for (int bj = 0; bj < 2; ++bj) {
            const f32x4 g0 = *(const f32x4*)(gp + bj * 128), g1 = *(const f32x4*)(gp + bj * 128 + 4);
            u32x4 rv[2][4];
#pragma unroll
            for (int ai = 0; ai < 2; ++ai)
#pragma unroll
                for (int m = 0; m < 4; ++m) rv[ai][m] = *(const u32x4*)(X1 + (size_t)(row0 + ai * 128 + m * 16) * D + col0 + bj * 128);
#pragma unroll
            for (int ai = 0; ai < 2; ++ai)
#pragma unroll
                for (int m = 0; m < 4; ++m) {
                    const size_t ro = (size_t)(row0 + ai * 128 + m * 16) * D + col0 + bj * 128;
                    const u32x4 r = rv[ai][m];
                    float v[8];
                    v[0] = lo_bf(r.x) + g0[0] * acc[ai][bj][m][0][0]; v[1] = hi_bf(r.x) + g0[1] * acc[ai][bj][m][0][1];
                    v[2] = lo_bf(r.y) + g0[2] * acc[ai][bj][m][0][2]; v[3] = hi_bf(r.y) + g0[3] * acc[ai][bj][m][0][3];
                    v[4] = lo_bf(r.z) + g1[0] * acc[ai][bj][m][1][0]; v[5] = hi_bf(r.z) + g1[1] * acc[ai][bj][m][1][1];
                    v[6] = lo_bf(r.w) + g1[2] * acc[ai][bj][m][1][2]; v[7] = hi_bf(r.w) + g1[3] * acc[ai][bj][m][1][3];
                    *(u32x4*)(X2 + ro) = pack8(v);
                }
        }
    }
};
struct EpiRes {
    static constexpr bool PERM = false, ROWPERM = false;
    const float* resid; float* out; const float* gate;
    __device__ __forceinline__ void operator()(const f32x4 (&acc)[2][2][4][2], const Unit& u, int wr, int wc, int fr, int fq) const {
        const int row0 = u.pm * 256 + wr * 64 + fr, col0 = u.pn * 256 + wc * 32 + 4 * fq;
        const float* gp = gate + (size_t)((u.pm * 256) / T) * 6144 + col0;
        f32x4 gv[2][2];
#pragma unroll
        for (int bj = 0; bj < 2; ++bj)
#pragma unroll
            for (int n = 0; n < 2; ++n) gv[bj][n] = *(const f32x4*)(gp + bj * 128 + n * 16);
#pragma unroll
        for (int ai = 0; ai < 2; ++ai)
#pragma unroll
            for (int m = 0; m < 4; ++m) {
                const size_t ro = (size_t)(row0 + ai * 128 + m * 16) * D + col0;
#pragma unroll
                for (int bj = 0; bj < 2; ++bj)
#pragma unroll
                    for (int n = 0; n < 2; ++n) {
                        const f32x4 r = *(const f32x4*)(resid + ro + bj * 128 + n * 16);
                        *(f32x4*)(out + ro + bj * 128 + n * 16) = r + gv[bj][n] * acc[ai][bj][m][n];
                    }
            }
    }
};

struct TileDesc { const float* src; bf16_t* dst; int ldsrc, ldd, k0, n0, mode; };
__device__ __forceinline__ void xpose_load(const TileDesc& d, int tid, float (&v)[8]) {
    const int nl = tid & 63, ks = tid >> 6, n = d.n0 + nl;
    int sc = n;
    if (d.mode == 2) sc = ((n & 255) >> 7) * DFF + 128 * (n >> 8) + (n & 127);
    if (d.mode == 1) { if (n < 2048) sc = n; else if (n < 3872) sc = n + 16; else if (n < 3888) sc = 2048 + (n - 3872); else if (n < 4096) sc = -1; else sc = n - 208; }
#pragma unroll
    for (int i = 0; i < 8; ++i) v[i] = sc >= 0 ? d.src[(size_t)(d.k0 + ks + 8 * i) * d.ldsrc + sc] : 0.f;
}
__device__ __forceinline__ void xpose_put(int tid, const float (&v)[8], LAS float* tile) {
    const int nl = tid & 63, ks = tid >> 6;
#pragma unroll
    for (int i = 0; i < 8; ++i) tile[(ks + 8 * i) * 65 + nl] = v[i];
}
__device__ __forceinline__ void xpose_store(const TileDesc& d, int tid, const LAS float* tile) {
    const int n_l = tid >> 3, kc = (tid & 7) * 8; const LAS float* s = tile + kc * 65 + n_l;
    u32x4 o; o.x = pk2(s[0], s[65]); o.y = pk2(s[130], s[195]); o.z = pk2(s[260], s[325]); o.w = pk2(s[390], s[455]);
    *(u32x4*)(d.dst + (size_t)(d.n0 + n_l) * d.ldd + d.k0 + kc) = o;
}
constexpr int XP_I0 = 16 * 96, XP_NIT = 16 * 96 + 2 * (8 * 16) + 16 * 16 + 16 * 88 + 44 * 16;
__device__ __forceinline__ void xpose_range(int wv, const Params& p, LAS unsigned char* lds, int first, int last, int start, int stride) {
    const int tid = opaque_tid(wv);
    LAS float* tile0 = (LAS float*)lds; LAS float* tile1 = tile0 + 64 * 65;
    bf16_t* wtin = (bf16_t*)(p.ws + WS_WTIN); bf16_t* wtbr = (bf16_t*)(p.ws + WS_WTBR); bf16_t* wtout = (bf16_t*)(p.ws + WS_WTOUT);
    bf16_t* wtf1 = (bf16_t*)(p.ws + WS_WTF1); bf16_t* wtf2 = (bf16_t*)(p.ws + WS_WTF2);
    constexpr int I0 = 16 * 96, I1 = 8 * 16, I3 = 16 * 16, I5 = 16 * 88, I6 = 44 * 16, NIT = I0 + 2 * I1 + I3 + I5 + I6;
    auto desc = [&](int it) -> TileDesc {
        int r = it;
        if (r < I0) return TileDesc{p.w_in, wtin, 5936, 1024, (r / 96) * 64, (r % 96) * 64, 1}; r -= I0;
        if (r < I1) return TileDesc{p.w_branch_gdn, wtbr, 1024, 512, (r / 16) * 64, (r % 16) * 64, 0}; r -= I1;
        if (r < I1) return TileDesc{p.w_branch_rwkv, wtbr + (size_t)1024 * 512, 1024, 512, (r / 16) * 64, (r % 16) * 64, 0}; r -= I1;
        if (r < I3) return TileDesc{p.w_out, wtout, 1024, 1024, (r / 16) * 64, (r % 16) * 64, 0}; r -= I3;
        if (r < I5) return TileDesc{p.w_ffn_in, wtf1, 5632, 1024, (r / 88) * 64, (r % 88) * 64, 2}; r -= I5;
        return TileDesc{p.w_ffn_out, wtf2, 1024, 2816, (r / 16) * 64, (r % 16) * 64, 0};
    };
    {
        const int G = stride;
        int it = first + start;
        bool hA = it < last, hB = it + G < last;
        float va[8], vb[8];
        if (hA) { const TileDesc d = desc(it); xpose_load(d, tid, va); }
        if (hB) { const TileDesc d = desc(it + G); xpose_load(d, tid, vb); }
        while (hA) {
            xpose_put(tid, va, tile0); if (hB) xpose_put(tid, vb, tile1);
            const int nit = it + 2 * G; const bool nA = nit < last, nB = nit + G < last;
            if (nA) { const TileDesc d = desc(nit); xpose_load(d, tid, va); }
            if (nB) { const TileDesc d = desc(nit + G); xpose_load(d, tid, vb); }
            __syncthreads();
            { const TileDesc d = desc(it); xpose_store(d, tid, tile0); }
            if (hB) { const TileDesc d = desc(it + G); xpose_store(d, tid, tile1); }
            __syncthreads();
            it = nit; hA = nA; hB = nB;
        }
    }
}
__device__ __forceinline__ void phase0(int wv, const Params& p, LAS unsigned char* lds) {
    const int tid = opaque_tid(wv);
    LAS float* tile0 = (LAS float*)lds; LAS float* tile1 = tile0 + 64 * 65;
    bf16_t* wtin = (bf16_t*)(p.ws + WS_WTIN); bf16_t* wtbr = (bf16_t*)(p.ws + WS_WTBR); bf16_t* wtout = (bf16_t*)(p.ws + WS_WTOUT);
    bf16_t* wtf1 = (bf16_t*)(p.ws + WS_WTF1); bf16_t* wtf2 = (bf16_t*)(p.ws + WS_WTF2); bf16_t* wtlo = (bf16_t*)(p.ws + WS_WTLO);
    float* mod = (float*)(p.ws + WS_MOD);
    LAS float* sc = (LAS float*)lds + 8192;
    LAS float* red = (LAS float*)lds + 8192 + 8192;
    for (int g = blockIdx.x; g < 192; g += gridDim.x) {
        for (int i = tid; i < 8192; i += 512) sc[i] = silu_(p.c[i]);
        __syncthreads();
        const int col = tid & 31, ks = tid >> 5, j = g * 32 + col;
        float a[8];
#pragma unroll
        for (int b = 0; b < 8; ++b) a[b] = 0.f;
        for (int i0 = 0; i0 < 64; i0 += 16) {
            float wq[16];
#pragma unroll
            for (int u = 0; u < 16; ++u) wq[u] = p.w_ada[(size_t)(ks + 16 * (i0 + u)) * 6144 + j];
#pragma unroll
            for (int u = 0; u < 16; ++u) { const int k = ks + 16 * (i0 + u);
#pragma unroll
                for (int b = 0; b < 8; ++b) a[b] += sc[b * 1024 + k] * wq[u]; }
        }
#pragma unroll
        for (int b = 0; b < 8; ++b) red[(ks * 8 + b) * 32 + col] = a[b];
        __syncthreads();
        if (tid < 256) { const int b = tid >> 5, cc = tid & 31; float sacc = p.b_ada[g * 32 + cc];
            for (int q = 0; q < 16; ++q) sacc += red[(q * 8 + b) * 32 + cc];
            mod[b * 6144 + g * 32 + cc] = sacc; }
        __syncthreads();
    }
    xpose_range(wv, p, lds, 0, XP_I0, blockIdx.x, gridDim.x);
    for (int idx = blockIdx.x * 512 + tid; idx < 1536 * 384; idx += gridDim.x * 512) {
        const int n = idx / 384, k = idx % 384; float v = 0.f;
        if (n < 512) { if (k < 64) v = p.w2[k * 512 + n]; }
        else if (n < 1024) { if (k >= 64 && k < 128) v = p.a2[(k - 64) * 512 + (n - 512)]; }
        else { if (k >= 128 && k < 288) v = p.g2[(k - 128) * 512 + (n - 1024)]; }
        wtlo[idx] = f2bf(v);
    }
}

__device__ __forceinline__ void norm_mod_phase(int wv, const float* src, const float* nw, const float* mod, int scale_off, int shift_off, bf16_t* dst) {
    const int tid_ = opaque_tid(wv); const int lane = tid_ & 63, gw = blockIdx.x * 8 + (tid_ >> 6), ngw = gridDim.x * 8;
    f32x4 w[4];
#pragma unroll
    for (int j = 0; j < 4; ++j) w[j] = *(const f32x4*)(nw + 4 * lane + 256 * j);
    f32x4 v[4], n1[4], n2[4];
#pragma unroll
    for (int j = 0; j < 4; ++j) { if (gw < NTOK) v[j] = ((const f32x4*)(src + (size_t)gw * D) + lane)[64 * j];
        if (gw + ngw < NTOK) n1[j] = ((const f32x4*)(src + (size_t)(gw + ngw) * D) + lane)[64 * j];
        if (gw + 2 * ngw < NTOK) n2[j] = ((const f32x4*)(src + (size_t)(gw + 2 * ngw) * D) + lane)[64 * j]; }
    for (int row = gw; row < NTOK; row += ngw) {
        f32x4 n3[4];
        if (row + 3 * ngw < NTOK) {
#pragma unroll
            for (int j = 0; j < 4; ++j) n3[j] = ((const f32x4*)(src + (size_t)(row + 3 * ngw) * D) + lane)[64 * j];
        }
        const float* mb = mod + (size_t)(row / T) * 6144;
        f32x4 scl[4], sh[4];
#pragma unroll
        for (int j = 0; j < 4; ++j) { scl[j] = *(const f32x4*)(mb + scale_off + 4 * lane + 256 * j); sh[j] = *(const f32x4*)(mb + shift_off + 4 * lane + 256 * j); }
        float s = 0.f;
#pragma unroll
        for (int j = 0; j < 4; ++j) s += (v[j].x * v[j].x + v[j].y * v[j].y) + (v[j].z * v[j].z + v[j].w * v[j].w);
        const float rstd = rsqrtf(wsum(s) * (1.f / D) + 1e-6f);
#pragma unroll
        for (int j = 0; j < 4; ++j) { const int c = 4 * lane + 256 * j;
            const f32x4 y = v[j] * rstd * w[j] * (scl[j] + 1.f) + sh[j];
            u32x2 o; o.x = pk2(y.x, y.y); o.y = pk2(y.z, y.w);
            *(u32x2*)(dst + (size_t)row * D + c) = o; }
#pragma unroll
        for (int j = 0; j < 4; ++j) { v[j] = n1[j]; n1[j] = n2[j]; n2[j] = n3[j]; }
    }
}
__device__ __forceinline__ void norm_mod_bf16_phase(int wv, const bf16_t* src, const float* nw, const float* mod, int scale_off, int shift_off, bf16_t* dst) {
    const int tid_ = opaque_tid(wv); const int lane = tid_ & 63, gw = blockIdx.x * 8 + (tid_ >> 6), ngw = gridDim.x * 8;
    f32x4 w[2][2];
#pragma unroll
    for (int j = 0; j < 2; ++j) { w[j][0] = *(const f32x4*)(nw + 8 * lane + 512 * j); w[j][1] = *(const f32x4*)(nw + 8 * lane + 512 * j + 4); }
    u32x4 v[2], n1[2], n2[2];
#pragma unroll
    for (int j = 0; j < 2; ++j) { if (gw < NTOK) v[j] = *(const u32x4*)(src + (size_t)gw * D + 8 * lane + 512 * j);
        if (gw + ngw < NTOK) n1[j] = *(const u32x4*)(src + (size_t)(gw + ngw) * D + 8 * lane + 512 * j);
        if (gw + 2 * ngw < NTOK) n2[j] = *(const u32x4*)(src + (size_t)(gw + 2 * ngw) * D + 8 * lane + 512 * j); }
    for (int row = gw; row < NTOK; row += ngw) {
        u32x4 n3[2];
        if (row + 3 * ngw < NTOK) {
#pragma unroll
            for (int j = 0; j < 2; ++j) n3[j] = *(const u32x4*)(src + (size_t)(row + 3 * ngw) * D + 8 * lane + 512 * j);
        }
        const float* mb = mod + (size_t)(row / T) * 6144;
        float f[2][8]; float s = 0.f;
#pragma unroll
        for (int j = 0; j < 2; ++j) { unpack8(v[j], f[j]);
#pragma unroll
            for (int i = 0; i < 8; ++i) s += f[j][i] * f[j][i]; }
        const float rstd = rsqrtf(wsum(s) * (1.f / D) + 1e-6f);
#pragma unroll
        for (int j = 0; j < 2; ++j) { const int c = 8 * lane + 512 * j;
            const f32x4 sc0 = *(const f32x4*)(mb + scale_off + c), sc1 = *(const f32x4*)(mb + scale_off + c + 4), sh0 = *(const f32x4*)(mb + shift_off + c), sh1 = *(const f32x4*)(mb + shift_off + c + 4);
            float o[8];
#pragma unroll
            for (int i = 0; i < 4; ++i) { o[i] = f[j][i] * rstd * w[j][0][i] * (sc0[i] + 1.f) + sh0[i]; o[4 + i] = f[j][4 + i] * rstd * w[j][1][i] * (sc1[i] + 1.f) + sh1[i]; }
            *(u32x4*)(dst + (size_t)row * D + c) = pack8(o); }
        v[0] = n1[0]; v[1] = n1[1]; n1[0] = n2[0]; n1[1] = n2[1]; n2[0] = n3[0]; n2[1] = n3[1];
    }
}
__device__ __forceinline__ void final_norm_phase(int wv, const bf16_t* src, float* out, const float* nw) {
    const int tid_ = opaque_tid(wv); const int lane = tid_ & 63, gw = blockIdx.x * 8 + (tid_ >> 6), ngw = gridDim.x * 8;
    f32x4 w[2][2];
#pragma unroll
    for (int j = 0; j < 2; ++j) { w[j][0] = *(const f32x4*)(nw + 8 * lane + 512 * j); w[j][1] = *(const f32x4*)(nw + 8 * lane + 512 * j + 4); }
    u32x4 v[2], n1[2], n2[2];
#pragma unroll
    for (int j = 0; j < 2; ++j) { if (gw < NTOK) v[j] = *(const u32x4*)(src + (size_t)gw * D + 8 * lane + 512 * j);
        if (gw + ngw < NTOK) n1[j] = *(const u32x4*)(src + (size_t)(gw + ngw) * D + 8 * lane + 512 * j);
        if (gw + 2 * ngw < NTOK) n2[j] = *(const u32x4*)(src + (size_t)(gw + 2 * ngw) * D + 8 * lane + 512 * j); }
    for (int row = gw; row < NTOK; row += ngw) {
        u32x4 n3[2];
        if (row + 3 * ngw < NTOK) {
#pragma unroll
            for (int j = 0; j < 2; ++j) n3[j] = *(const u32x4*)(src + (size_t)(row + 3 * ngw) * D + 8 * lane + 512 * j);
        }
        float f[2][8]; float s = 0.f;
#pragma unroll
        for (int j = 0; j < 2; ++j) { unpack8(v[j], f[j]);
#pragma unroll
            for (int i = 0; i < 8; ++i) s += f[j][i] * f[j][i]; }
        const float rstd = rsqrtf(wsum(s) * (1.f / D) + 1e-6f);
#pragma unroll
        for (int j = 0; j < 2; ++j) { float* o = out + (size_t)row * D + 8 * lane + 512 * j;
            f32x4 o0, o1;
#pragma unroll
            for (int i = 0; i < 4; ++i) { o0[i] = f[j][i] * rstd * w[j][0][i]; o1[i] = f[j][4 + i] * rstd * w[j][1][i]; }
            *(f32x4*)o = o0; *(f32x4*)(o + 4) = o1; }
        v[0] = n1[0]; v[1] = n1[1]; n1[0] = n2[0]; n1[1] = n2[1]; n2[0] = n3[0]; n2[1] = n3[1];
    }
}

__device__ __forceinline__ void alo_phase(int wv, const Params& p, const bf16_t* P, bf16_t* ALO) {
    const int total = NTOK * 48;
    for (int idx = blockIdx.x * 512 + opaque_tid(wv); idx < total; idx += gridDim.x * 512) {
        const int tok = idx / 48, j0 = (idx % 48) * 8;
        u32x4 o = (u32x4){0u, 0u, 0u, 0u};
        if (j0 < 288) {
            const u32x4 cu = *(const u32x4*)(P + (size_t)tok * LDP + PC_LO + j0);
            u32x4 pu = (u32x4){0u, 0u, 0u, 0u};
            if ((tok % T) != 0) pu = *(const u32x4*)(P + (size_t)(tok - 1) * LDP + PC_LO + j0);
            const f32x4 m0 = *(const f32x4*)(p.mu_rwkv + 1536 + j0), m1 = *(const f32x4*)(p.mu_rwkv + 1536 + j0 + 4);
            float v[8], q[8];
            v[0] = lo_bf(cu.x); v[1] = hi_bf(cu.x); v[2] = lo_bf(cu.y); v[3] = hi_bf(cu.y); v[4] = lo_bf(cu.z); v[5] = hi_bf(cu.z); v[6] = lo_bf(cu.w); v[7] = hi_bf(cu.w);
            q[0] = lo_bf(pu.x); q[1] = hi_bf(pu.x); q[2] = lo_bf(pu.y); q[3] = hi_bf(pu.y); q[4] = lo_bf(pu.z); q[5] = hi_bf(pu.z); q[6] = lo_bf(pu.w); q[7] = hi_bf(pu.w);
#pragma unroll
            for (int i = 0; i < 8; ++i) { const float mu = i < 4 ? m0[i] : m1[i - 4]; float m = v[i] + (q[i] - v[i]) * mu;
                if (j0 < 64) m = 1.f - 2.f * __builtin_amdgcn_rcpf(1.f + __expf(2.f * m)); else if (j0 >= 128) m = sigm(m);
                v[i] = m; }
            o.x = pk2(v[0], v[1]); o.y = pk2(v[2], v[3]); o.z = pk2(v[4], v[5]); o.w = pk2(v[6], v[7]);
        }
        *(u32x4*)(ALO + (size_t)tok * LDALO + j0) = o;
    }
}

constexpr int TC = 32, VEC = TC * 64, SCOFF = 5 * VEC + TC * 32, PEOFF = SCOFF + TC * 2, INBUF = PEOFF + 64;
struct StepR { f32x2 r[4], k[4], a[4], b[4]; float v; };
struct StepG { f32x2 r[4], a[4]; float v; f32x2 ab; };
__device__ __forceinline__ void ld_stepR(StepR& s, const LAS float* lb, const LAS float* vb, int t) {
    const LAS float* base = lb + t * 64;
#pragma unroll
    for (int i = 0; i < 4; ++i) { s.r[i] = *(const LAS f32x2*)(base + 2 * i); s.k[i] = *(const LAS f32x2*)(base + 2 * VEC + 2 * i);
        s.a[i] = *(const LAS f32x2*)(base + 3 * VEC + 2 * i); s.b[i] = *(const LAS f32x2*)(base + 4 * VEC + 2 * i); }
    s.v = vb[t * 32];
}
__device__ __forceinline__ void ld_stepG(StepG& s, const LAS float* lb, const LAS float* vb, const LAS float* sb, int t) {
    const LAS float* base = lb + t * 64;
#pragma unroll
    for (int i = 0; i < 4; ++i) { s.r[i] = *(const LAS f32x2*)(base + 2 * i); s.a[i] = *(const LAS f32x2*)(base + 3 * VEC + 2 * i); }
    s.v = vb[t * 32]; s.ab = *(const LAS f32x2*)(sb + 2 * t);
}
__device__ __forceinline__ float do_stepR(f32x2 (&S)[4], const StepR& s) {
    f32x2 d = S[0] * s.a[0]; f32x2 d2 = S[1] * s.a[1]; d = S[2] * s.a[2] + d; d2 = S[3] * s.a[3] + d2; d = d + d2;
    const f32x2 v2 = (f32x2){s.v, s.v};
    f32x2 u[4];
#pragma unroll
    for (int i = 0; i < 4; ++i) u[i] = v2 * s.k[i] + S[i];
    const float sa = red8(d.x + d.y);
    const f32x2 sa2 = (f32x2){sa, sa};
#pragma unroll
    for (int i = 0; i < 4; ++i) S[i] = sa2 * s.b[i] + u[i];
    f32x2 e = S[0] * s.r[0]; f32x2 e2 = S[1] * s.r[1]; e = S[2] * s.r[2] + e; e2 = S[3] * s.r[3] + e2; e = e + e2;
    return e.x + e.y;
}
__device__ __forceinline__ float do_stepG(f32x2 (&S)[4], const StepG& s) {
    f32x2 d = S[0] * s.a[0]; f32x2 d2 = S[1] * s.a[1]; d = S[2] * s.a[2] + d; d2 = S[3] * s.a[3] + d2; d = d + d2;
    const f32x2 al2 = (f32x2){s.ab.x, s.ab.x};
    f32x2 u[4];
#pragma unroll
    for (int i = 0; i < 4; ++i) u[i] = S[i] * al2;
    const float sa = red8(d.x + d.y);
    const float coef = s.ab.y * (s.v - s.ab.x * sa);
    const f32x2 c2 = (f32x2){coef, coef};
#pragma unroll
    for (int i = 0; i < 4; ++i) S[i] = c2 * s.a[i] + u[i];
    f32x2 e = S[0] * s.r[0]; f32x2 e2 = S[1] * s.r[1]; e = S[2] * s.r[2] + e; e2 = S[3] * s.r[3] + e2; e = e + e2;
    return e.x + e.y;
}
__device__ __forceinline__ void lora_phase(int wv, const Params& p, LAS unsigned char* lds, const bf16_t* P, const bf16_t* wtlo, bf16_t* LO) {
    const int tid = opaque_tid(wv), lane = tid & 63, r = lane & 15, q = lane >> 4;
    LAS float* bias = (LAS float*)(lds + 98304);
    for (int i = tid; i < 1024; i += 512) bias[i] = i < 512 ? p.w0[i] : p.a0[i - 512];
    for (int base = blockIdx.x * 8; base < NTOK / 16; base += gridDim.x * 8) {
        const int tile = base + wv;
        const int tok = tile * 16 + r;
        const bf16_t* cur = P + (size_t)tok * LDP + PC_LO + q * 8;
        const bool has_prev = (tok % T) != 0;
        const bf16_t* prv = has_prev ? cur - LDP : cur;
        const float pm = has_prev ? 1.f : 0.f;
        u32x4 cu[9], pu[9];
#pragma unroll
        for (int ks = 0; ks < 9; ++ks) { cu[ks] = *(const u32x4*)(cur + ks * 32); pu[ks] = *(const u32x4*)(prv + ks * 32); }
        u32x4 st0[8];
#pragma unroll
        for (int i = 0; i < 8; ++i) { const int c = tid + 512 * i; st0[i] = *(const u32x4*)(wtlo + (size_t)(c >> 3) * LDALO + (c & 7) * 8); }
        bf16x8 af[9];
#pragma unroll
        for (int ks = 0; ks < 9; ++ks) {
            const f32x4 m0 = *(const f32x4*)(p.mu_rwkv + 1536 + ks * 32 + q * 8), m1 = *(const f32x4*)(p.mu_rwkv + 1536 + ks * 32 + q * 8 + 4);
            float v[8], pv[8]; unpack8(cu[ks], v); unpack8(pu[ks], pv);
#pragma unroll
            for (int i = 0; i < 8; ++i) { const float mu = i < 4 ? m0[i] : m1[i - 4]; float m = v[i] + (pv[i] * pm - v[i]) * mu;
                if (ks < 2) m = 1.f - 2.f * __builtin_amdgcn_rcpf(1.f + __expf(2.f * m)); else if (ks >= 4) m = sigm(m);
                v[i] = m; }
            const u32x4 pk = pack8(v);
            af[ks] = __builtin_bit_cast(bf16x8, pk);
        }
        bf16_t* orow = LO + (size_t)tok * LDLO + 8 * q;
        const int rsl = 8 * (r >> 2) + (r & 3);
        u32x4 st[10];
#pragma unroll
        for (int i = 0; i < 8; ++i) st[i] = st0[i];
#define LORA_LOAD(N0, NROWS, KS0, NKS) do { constexpr int CPR = (NKS) * 4; \
            _Pragma("unroll") for (int i = 0; i < (NROWS) * CPR / 512; ++i) { const int c = tid + 512 * i, row = c / CPR, kc = c % CPR; \
                st[i] = *(const u32x4*)(wtlo + (size_t)((N0) + row) * LDALO + (KS0) * 32 + kc * 8); } } while (0)
#define LORA_WRITE(NROWS, NKS) do { constexpr int RSB = (NKS) * 64 + 16, CPR = (NKS) * 4; \
            _Pragma("unroll") for (int i = 0; i < (NROWS) * CPR / 512; ++i) { const int c = tid + 512 * i, row = c / CPR, kc = c % CPR; \
                *(LAS u32x4*)(lds + row * RSB + kc * 16) = st[i]; } } while (0)
#define LORA_PAIRS(N0, NROWS, KS0, NKS, REGION) do { constexpr int RSB = (NKS) * 64 + 16; \
            _Pragma("unroll 2") for (int pl = 0; pl < (NROWS) / 32; ++pl) { \
                const f32x4 zero4 = (f32x4){0.f, 0.f, 0.f, 0.f}; \
                const LAS unsigned char* b0 = lds + (32 * pl + rsl) * RSB + q * 16; const LAS unsigned char* b1 = b0 + 4 * RSB; \
                bf16x8 w0f[NKS], w1f[NKS]; f32x4 pa0[NKS], pa1[NKS]; \
                _Pragma("unroll") for (int kk = 0; kk < (NKS); ++kk) { w0f[kk] = *(const LAS bf16x8*)(b0 + kk * 64); w1f[kk] = *(const LAS bf16x8*)(b1 + kk * 64); } \
                  \
                _Pragma("unroll") for (int kk = 0; kk < (NKS); ++kk) { \
                    pa0[kk] = __builtin_amdgcn_mfma_f32_16x16x32_bf16(w0f[kk], af[(KS0) + kk], zero4, 0, 0, 0); \
                    pa1[kk] = __builtin_amdgcn_mfma_f32_16x16x32_bf16(w1f[kk], af[(KS0) + kk], zero4, 0, 0, 0); } \
                _Pragma("unroll") for (int kk = 0; kk < (NKS); ++kk) asm volatile("" : "+v"(pa0[kk]), "+v"(pa1[kk])); \
                asm volatile("s_nop 15\n\ts_nop 15" ::: "memory"); \
                _Pragma("unroll") for (int kk = 0; kk < (NKS); ++kk) asm volatile("" : "+v"(pa0[kk]), "+v"(pa1[kk])); \
                f32x4 acc0 = pa0[0], acc1 = pa1[0]; \
                _Pragma("unroll") for (int kk = 1; kk < (NKS); ++kk) { acc0 = acc0 + pa0[kk]; acc1 = acc1 + pa1[kk]; } \
                const int n0 = (N0) + 32 * pl + 8 * q; float o[8]; \
                if ((REGION) < 2) { const LAS float* bs = bias + ((REGION) == 0 ? 0 : 512) + (n0 & 511); const f32x4 c0 = *(const LAS f32x4*)bs, c1 = *(const LAS f32x4*)(bs + 4); \
                    const float sc = (REGION) == 0 ? 0.60653066f : 1.f; \
                    _Pragma("unroll") for (int j = 0; j < 4; ++j) { o[j] = sc * sigm(acc0[j] + c0[j]); o[4 + j] = sc * sigm(acc1[j] + c1[j]); } } \
                else { _Pragma("unroll") for (int j = 0; j < 4; ++j) { o[j] = acc0[j]; o[4 + j] = acc1[j]; } } \
                *(u32x4*)(orow + (N0) + 32 * pl) = pack8(o); } } while (0)
        __syncthreads(); LORA_WRITE(512, 2); LORA_LOAD(512, 512, 2, 2);   __syncthreads(); LORA_PAIRS(0, 512, 0, 2, 0);
        __syncthreads(); LORA_WRITE(512, 2); LORA_LOAD(1024, 256, 4, 5);  __syncthreads(); LORA_PAIRS(512, 512, 2, 2, 1);
        __syncthreads(); LORA_WRITE(256, 5); LORA_LOAD(1280, 256, 4, 5);  __syncthreads(); LORA_PAIRS(1024, 256, 4, 5, 2);
        __syncthreads(); LORA_WRITE(256, 5);                              __syncthreads(); LORA_PAIRS(1280, 256, 4, 5, 2);
#undef LORA_LOAD
#undef LORA_WRITE
#undef LORA_PAIRS
    }
    __syncthreads();
}

struct B4 { float g[4][3]; float rw[4][3]; float bl[4], al[4], e[4], asg[4]; };
__device__ __forceinline__ void unpack4f(const u32x2 u, float (&v)[4]) { v[0] = lo_bf(u.x); v[1] = hi_bf(u.x); v[2] = lo_bf(u.y); v[3] = hi_bf(u.y); }
__device__ __forceinline__ u32x2 pack4f(const float (&v)[4]) { u32x2 o; o.x = pk2(v[0], v[1]); o.y = pk2(v[2], v[3]); return o; }
__device__ __forceinline__ float red16f(float x) { x += dpp_f(x, 0); x += dpp_f(x, 1); x += dpp_f(x, 2); x += dpp_rm(x); return x; }
struct PRaw { u32x2 gq, gk, gv, rr, rk, rv, le, la; float bl, al; };
__device__ __forceinline__ void prep2_phase(int wv, const Params& p, bf16_t* P, float* BA, const bf16_t* HALO, bf16_t* LO, float* PEND) {
    const int tid = opaque_tid(wv), lane = tid & 63, cq = wv >> 1, hh = wv & 1;
    const int c0 = 256 * hh + 4 * lane, h = c0 >> 6;
    float cw[4][3][4], mur[4], muk[4], muv[4], kkc[4], kac[4];
#pragma unroll
    for (int j = 0; j < 4; ++j)
#pragma unroll
        for (int s3 = 0; s3 < 3; ++s3) { const f32x4 t = *(const f32x4*)(p.conv_gdn + j * 1536 + s3 * 512 + c0); cw[j][s3][0] = t.x; cw[j][s3][1] = t.y; cw[j][s3][2] = t.z; cw[j][s3][3] = t.w; }
    { const f32x4 a = *(const f32x4*)(p.mu_rwkv + c0), b2 = *(const f32x4*)(p.mu_rwkv + 512 + c0), c2 = *(const f32x4*)(p.mu_rwkv + 1024 + c0), d2 = *(const f32x4*)(p.k_k + c0), e2 = *(const f32x4*)(p.k_a + c0);
#pragma unroll
      for (int i = 0; i < 4; ++i) { mur[i] = a[i]; muk[i] = b2[i]; muv[i] = c2[i]; kkc[i] = d2[i]; kac[i] = e2[i]; } }
    const float nA = -expf(p.a_log[h]), dtb = p.dt_bias[h];
    for (int blk = blockIdx.x; blk < NTOK / 128; blk += gridDim.x) {
        const int tok0 = blk * 128, t0 = tok0 + 32 * cq;
        float xw[3][3][4], pv[3][4];
        if (cq == 0) {
            if ((tok0 % T) != 0) {
                const bf16_t* hr = HALO + (size_t)(blk - 1) * 3 * 3072;
#pragma unroll
                for (int r = 0; r < 3; ++r)
#pragma unroll
                    for (int s3 = 0; s3 < 3; ++s3) unpack4f(*(const u32x2*)(hr + r * 3072 + s3 * 512 + c0), xw[r][s3]);
#pragma unroll
                for (int s3 = 0; s3 < 3; ++s3) unpack4f(*(const u32x2*)(hr + 2 * 3072 + 1536 + s3 * 512 + c0), pv[s3]);
            } else {
#pragma unroll
                for (int r = 0; r < 3; ++r)
#pragma unroll
                    for (int s3 = 0; s3 < 3; ++s3)
#pragma unroll
                        for (int i = 0; i < 4; ++i) xw[r][s3][i] = 0.f;
#pragma unroll
                for (int s3 = 0; s3 < 3; ++s3)
#pragma unroll
                    for (int i = 0; i < 4; ++i) pv[s3][i] = 0.f;
            }
        } else {
#pragma unroll
            for (int r = 0; r < 3; ++r)
#pragma unroll
                for (int s3 = 0; s3 < 3; ++s3) unpack4f(*(const u32x2*)(P + (size_t)(t0 - 3 + r) * LDP + s3 * 512 + c0), xw[r][s3]);
#pragma unroll
            for (int s3 = 0; s3 < 3; ++s3) unpack4f(*(const u32x2*)(P + (size_t)(t0 - 1) * LDP + PC_RB + s3 * 512 + c0), pv[s3]);
        }
        auto load = [&](int t, PRaw& w) {
            const size_t tok = (size_t)t0 + t; const bf16_t* row = P + tok * LDP + c0; const bf16_t* lo = LO + tok * LDLO + c0;
            w.gq = *(const u32x2*)row; w.gk = *(const u32x2*)(row + 512); w.gv = *(const u32x2*)(row + 1024);
            w.rr = *(const u32x2*)(row + PC_RB); w.rk = *(const u32x2*)(row + PC_RB + 512); w.rv = *(const u32x2*)(row + PC_RB + 1024);
            w.le = *(const u32x2*)lo; w.la = *(const u32x2*)(lo + 512);
            w.bl = BA[tok * 16 + h]; w.al = BA[tok * 16 + 8 + h];
        };
        PRaw cur, n1, n2;
        load(0, cur); load(1, n1); load(2, n2);
        __syncthreads();
        float G[4], Pprev[4];
#pragma unroll
        for (int i = 0; i < 4; ++i) { G[i] = 0.f; Pprev[i] = 1.f; }
        for (int t = 0; t < 32; ++t) {
            PRaw n3; if (t + 3 < 32) load(t + 3, n3);
            const size_t tok = (size_t)t0 + t; bf16_t* row = P + tok * LDP + c0;
            float gq[4], gk[4], gv[4]; unpack4f(cur.gq, gq); unpack4f(cur.gk, gk); unpack4f(cur.gv, gv);
            float q[4], k[4], v[4], sq = 0.f, sk = 0.f;
#pragma unroll
            for (int i = 0; i < 4; ++i) {
                q[i] = silu_(cw[0][0][i] * xw[0][0][i] + cw[1][0][i] * xw[1][0][i] + cw[2][0][i] * xw[2][0][i] + cw[3][0][i] * gq[i]);
                k[i] = silu_(cw[0][1][i] * xw[0][1][i] + cw[1][1][i] * xw[1][1][i] + cw[2][1][i] * xw[2][1][i] + cw[3][1][i] * gk[i]);
                v[i] = silu_(cw[0][2][i] * xw[0][2][i] + cw[1][2][i] * xw[1][2][i] + cw[2][2][i] * xw[2][2][i] + cw[3][2][i] * gv[i]);
                sq += q[i] * q[i]; sk += k[i] * k[i];
                xw[0][0][i] = xw[1][0][i]; xw[1][0][i] = xw[2][0][i]; xw[2][0][i] = gq[i];
                xw[0][1][i] = xw[1][1][i]; xw[1][1][i] = xw[2][1][i]; xw[2][1][i] = gk[i];
                xw[0][2][i] = xw[1][2][i]; xw[1][2][i] = xw[2][2][i]; xw[2][2][i] = gv[i];
            }
            const float rq = rsqrtf(red16f(sq) + 1e-6f) * 0.125f, rk_ = rsqrtf(red16f(sk) + 1e-6f);
#pragma unroll
            for (int i = 0; i < 4; ++i) { q[i] *= rq; k[i] *= rk_; }
            *(u32x2*)row = pack4f(q); *(u32x2*)(row + 512) = pack4f(k); *(u32x2*)(row + 1024) = pack4f(v);
            const float spx = cur.al + dtb;
            const float beta = sigm(cur.bl), alpha = __expf(nA * (spx > 15.f ? spx : __logf(1.f + __expf(spx))));
            if ((lane & 15) == 0) { BA[tok * 16 + h] = beta; BA[tok * 16 + 8 + h] = alpha; }
            float r[4], k2[4], v2[4], e[4], asg[4]; unpack4f(cur.rr, r); unpack4f(cur.rk, k2); unpack4f(cur.rv, v2); unpack4f(cur.le, e); unpack4f(cur.la, asg);
            float rm[4], km[4], vm[4], kx[4], skk = 0.f;
#pragma unroll
            for (int i = 0; i < 4; ++i) {
                rm[i] = r[i] + (pv[0][i] - r[i]) * mur[i]; km[i] = k2[i] + (pv[1][i] - k2[i]) * muk[i]; vm[i] = v2[i] + (pv[2][i] - v2[i]) * muv[i];
                pv[0][i] = r[i]; pv[1][i] = k2[i]; pv[2][i] = v2[i];
                kx[i] = km[i] * kkc[i]; skk += kx[i] * kx[i];
            }
            const float rkk = rsqrtf(red16f(skk) + 1e-6f);
            float o_r[4], o_k[4], o_a[4], o_b[4], pc[4];
#pragma unroll
            for (int i = 0; i < 4; ++i) {
                const float kkn = kx[i] * rkk, Pp = Pprev[i];
                G[i] += e[i]; const float Pc = __expf(-G[i]), iP = __expf(G[i]); Pprev[i] = Pc; pc[i] = Pc;
                const float kt = km[i] * (1.f + (asg[i] - 1.f) * kac[i]);
                o_r[i] = rm[i] * Pc; o_k[i] = kt * iP; o_a[i] = kkn * Pp; o_b[i] = kkn * asg[i] * iP;
            }
            *(u32x2*)(row + PC_RB) = pack4f(o_r); *(u32x2*)(row + PC_RB + 512) = pack4f(o_k); *(u32x2*)(row + PC_RB + 1024) = pack4f(vm); *(u32x2*)(row + PC_RB + 1536) = pack4f(o_a);
            *(u32x2*)(LO + tok * LDLO + c0) = pack4f(o_b);
            if (t == 31) *(f32x4*)(PEND + (tok >> 5) * 512 + c0) = (f32x4){pc[0], pc[1], pc[2], pc[3]};
            cur = n1; n1 = n2; n2 = n3;
        }
        __syncthreads();
    }
}

struct Raw { u32x4 a, b, c, d, e; float s0, s1; f32x4 p0, p1; };
__device__ __forceinline__ void scan_phase(int wv, const Params& p, LAS unsigned char* lds, const bf16_t* P, const float* BA, const bf16_t* LO, const float* PEND, bf16_t* Y) {
    const int tid = opaque_tid(wv), wave = tid >> 6, lane = tid & 63;
    LAS float* fl = (LAS float*)lds;
    LAS float* yb = fl + 2 * INBUF;
    for (int item = blockIdx.x; item < 256; item += gridDim.x) {
        const int s = item >> 1, half = item & 1, br = s >> 6, b = (s >> 3) & 7, h = s & 7;
        const int ht = tid - 256, tt = (ht >> 3) & 31, cgp = ht & 7;
        Raw raw;
        auto load_raw = [&](int ch) {
            const size_t tok = (size_t)b * T + ch * TC + tt;
            if (br == 0) {
                const bf16_t* row = P + tok * LDP + h * 64 + 8 * cgp;
                raw.a = *(const u32x4*)row; raw.b = *(const u32x4*)(row + 512); raw.c = *(const u32x4*)(row + 1024);
                raw.s0 = BA[tok * 16 + h]; raw.s1 = BA[tok * 16 + 8 + h];
            } else {
                const bf16_t* row = P + tok * LDP + PC_RB + h * 64 + 8 * cgp;
                raw.a = *(const u32x4*)row; raw.b = *(const u32x4*)(row + 512); raw.c = *(const u32x4*)(row + 1024); raw.d = *(const u32x4*)(row + 1536);
                raw.e = *(const u32x4*)(LO + tok * LDLO + h * 64 + 8 * cgp);
                if (tt == 0) { const float* pe = PEND + ((size_t)b * (T / TC) + ch) * 512 + h * 64 + 8 * cgp; raw.p0 = *(const f32x4*)pe; raw.p1 = *(const f32x4*)(pe + 4); }
            }
        };
        auto compute = [&](int ch) {
            LAS float* bb = fl + (ch & 1) * INBUF;
            LAS float* buf = bb + tt * 64 + 8 * cgp;
            float R[8], V[8];
            if (br == 0) {
                float kh[8]; unpack8(raw.a, R); unpack8(raw.b, kh); unpack8(raw.c, V);
                *(LAS f32x4*)(buf + 3 * VEC) = (f32x4){kh[0], kh[1], kh[2], kh[3]}; *(LAS f32x4*)(buf + 3 * VEC + 4) = (f32x4){kh[4], kh[5], kh[6], kh[7]};
                if (cgp == 0) *(LAS f32x2*)(bb + SCOFF + 2 * tt) = (f32x2){raw.s1, raw.s0};
            } else {
                float K[8], A[8], Bv[8]; unpack8(raw.a, R); unpack8(raw.b, K); unpack8(raw.c, V); unpack8(raw.d, A); unpack8(raw.e, Bv);
                *(LAS f32x4*)(buf + 2 * VEC) = (f32x4){K[0], K[1], K[2], K[3]}; *(LAS f32x4*)(buf + 2 * VEC + 4) = (f32x4){K[4], K[5], K[6], K[7]};
                *(LAS f32x4*)(buf + 3 * VEC) = (f32x4){-A[0], -A[1], -A[2], -A[3]}; *(LAS f32x4*)(buf + 3 * VEC + 4) = (f32x4){-A[4], -A[5], -A[6], -A[7]};
                *(LAS f32x4*)(buf + 4 * VEC) = (f32x4){Bv[0], Bv[1], Bv[2], Bv[3]}; *(LAS f32x4*)(buf + 4 * VEC + 4) = (f32x4){Bv[4], Bv[5], Bv[6], Bv[7]};
                if (tt == 0) { *(LAS f32x4*)(bb + PEOFF + 8 * cgp) = raw.p0; *(LAS f32x4*)(bb + PEOFF + 8 * cgp + 4) = raw.p1; }
            }
            *(LAS f32x4*)(buf) = (f32x4){R[0], R[1], R[2], R[3]}; *(LAS f32x4*)(buf + 4) = (f32x4){R[4], R[5], R[6], R[7]};
            if ((cgp >> 2) == half) { LAS float* vb = bb + 5 * VEC + tt * 32 + 8 * (cgp & 3);
                *(LAS f32x4*)vb = (f32x4){V[0], V[1], V[2], V[3]}; *(LAS f32x4*)(vb + 4) = (f32x4){V[4], V[5], V[6], V[7]}; }
        };
        auto flush = [&](int ch) {
            const LAS float* ys = yb + (ch & 1) * (TC * 128) + tt * 128 + 16 * cgp;
            float y[4];
#pragma unroll
            for (int i = 0; i < 4; ++i) { const f32x4 v = *(const LAS f32x4*)(ys + 4 * i); y[i] = (v.x + v.y) + (v.z + v.w); }
            u32x2 o; o.x = pk2(y[0], y[1]); o.y = pk2(y[2], y[3]);
            *(u32x2*)(Y + ((size_t)b * T + ch * TC + tt) * 1024 + br * 512 + h * 64 + half * 32 + 4 * cgp) = o;
        };
        constexpr int NCH = T / TC;
        if (wave >= 4) { load_raw(0); compute(0); load_raw(1); }
        __syncthreads();
        f32x2 S[4];
#pragma unroll
        for (int i = 0; i < 4; ++i) S[i] = (f32x2){0.f, 0.f};
        const int cg = lane & 7, lrow = wave * 8 + (lane >> 3);
        for (int ch = 0; ch < NCH; ++ch) {
            if (wave < 4) {
                __builtin_amdgcn_s_setprio(3);
                const LAS float* buf = fl + (ch & 1) * INBUF; const LAS float* lb = buf + 8 * cg; const LAS float* vb = buf + 5 * VEC + lrow;
                LAS float* ys = yb + (ch & 1) * (TC * 128) + lrow * 4 + (cg >> 1);
                if (br) {
                    StepR sa_, sb_, sc_, sd_;
                    ld_stepR(sa_, lb, vb, 0); ld_stepR(sb_, lb, vb, 1);
#pragma unroll
                    for (int t = 0; t < TC; t += 4) {
                        ld_stepR(sc_, lb, vb, t + 2);
                        float y0 = do_stepR(S, sa_);
                        ld_stepR(sd_, lb, vb, t + 3);
                        float y1 = do_stepR(S, sb_);
                        if (t + 4 < TC) ld_stepR(sa_, lb, vb, t + 4);
                        float y2 = do_stepR(S, sc_);
                        if (t + 5 < TC) ld_stepR(sb_, lb, vb, t + 5);
                        float y3 = do_stepR(S, sd_);
                        y0 += dpp_f(y0, 0); y1 += dpp_f(y1, 0); y2 += dpp_f(y2, 0); y3 += dpp_f(y3, 0);
                        if ((cg & 1) == 0) { ys[t * 128] = y0; ys[(t + 1) * 128] = y1; ys[(t + 2) * 128] = y2; ys[(t + 3) * 128] = y3; }
                    }
#pragma unroll
                    for (int i = 0; i < 4; ++i) S[i] = S[i] * *(const LAS f32x2*)(buf + PEOFF + 8 * cg + 2 * i);
                } else {
                    const LAS float* sb = buf + SCOFF;
                    StepG sa_, sb_, sc_, sd_;
                    ld_stepG(sa_, lb, vb, sb, 0); ld_stepG(sb_, lb, vb, sb, 1);
#pragma unroll
                    for (int t = 0; t < TC; t += 4) {
                        ld_stepG(sc_, lb, vb, sb, t + 2);
                        float y0 = do_stepG(S, sa_);
                        ld_stepG(sd_, lb, vb, sb, t + 3);
                        float y1 = do_stepG(S, sb_);
                        if (t + 4 < TC) ld_stepG(sa_, lb, vb, sb, t + 4);
                        float y2 = do_stepG(S, sc_);
                        if (t + 5 < TC) ld_stepG(sb_, lb, vb, sb, t + 5);
                        float y3 = do_stepG(S, sd_);
                        y0 += dpp_f(y0, 0); y1 += dpp_f(y1, 0); y2 += dpp_f(y2, 0); y3 += dpp_f(y3, 0);
                        if ((cg & 1) == 0) { ys[t * 128] = y0; ys[(t + 1) * 128] = y1; ys[(t + 2) * 128] = y2; ys[(t + 3) * 128] = y3; }
                    }
                }
                __builtin_amdgcn_s_setprio(0);
            } else {
                if (ch + 1 < NCH) compute(ch + 1);
                if (ch + 2 < NCH) load_raw(ch + 2);
                if (ch > 0) flush(ch - 1);
            }
            __syncthreads();
        }
        if (wave >= 4) flush(NCH - 1);
        __syncthreads();
    }
    if (gridDim.x >= 256 ? blockIdx.x < 128 : true) xpose_range(wv, p, lds, XP_I0, XP_NIT, gridDim.x >= 256 ? (int)blockIdx.x : (int)blockIdx.x, gridDim.x >= 256 ? 128 : (int)gridDim.x);
}

struct PostRaw { u32x4 ya, z, yb, r, k, v, asg, g; };
__device__ __forceinline__ void post_phase(int wv, const Params& p, const bf16_t* P, const bf16_t* LO, bf16_t* Y) {
    const int tid_ = opaque_tid(wv); const int lane = tid_ & 63, gw = blockIdx.x * 8 + (tid_ >> 6), ngw = gridDim.x * 8;
    const int c0 = lane * 8;
    float onw[8], lw[8], lb[8], ka[8], rk[8];
#pragma unroll
    for (int i = 0; i < 8; ++i) { onw[i] = p.onorm_gdn[(c0 + i) & 63]; lw[i] = p.lnx_w[c0 + i]; lb[i] = p.lnx_b[c0 + i]; ka[i] = p.k_a[c0 + i]; rk[i] = p.r_k[c0 + i]; }
    auto load = [&](int tok, PostRaw& w) {
        const bf16_t* yr = Y + (size_t)tok * 1024 + c0; const bf16_t* pr = P + (size_t)tok * LDP + c0; const bf16_t* lo = LO + (size_t)tok * LDLO + c0;
        w.ya = *(const u32x4*)yr; w.yb = *(const u32x4*)(yr + 512); w.z = *(const u32x4*)(pr + PC_Z);
        w.r = *(const u32x4*)(pr + PC_RB); w.k = *(const u32x4*)(pr + PC_RB + 512); w.v = *(const u32x4*)(pr + PC_RB + 1024);
        w.asg = *(const u32x4*)(lo + 512); w.g = *(const u32x4*)(lo + 1024);
    };
    PostRaw cur, nxt;
    if (gw < NTOK) load(gw, cur);
    for (int tok = gw; tok < NTOK; tok += ngw) {
        const bool hn = tok + ngw < NTOK;
        if (hn) load(tok + ngw, nxt);
        bf16_t* yr = Y + (size_t)tok * 1024 + c0;
        {
            float o[8], z[8]; unpack8(cur.ya, o); unpack8(cur.z, z);
            float ss = 0.f;
#pragma unroll
            for (int i = 0; i < 8; ++i) ss += o[i] * o[i];
            ss = red8(ss);
            const float rs = rsqrtf(ss * (1.f / 64.f) + 1e-6f);
#pragma unroll
            for (int i = 0; i < 8; ++i) o[i] = o[i] * rs * onw[i] * silu_(z[i]);
            *(u32x4*)yr = pack8(o);
        }
        {
            float y[8], r[8], k[8], v[8], a[8], g[8];
            unpack8(cur.yb, y); unpack8(cur.r, r); unpack8(cur.k, k); unpack8(cur.v, v); unpack8(cur.asg, a); unpack8(cur.g, g);
            float sm = 0.f, sb = 0.f;
#pragma unroll
            for (int i = 0; i < 8; ++i) { sm += y[i]; sb += r[i] * k[i] * rk[i]; }
            const float mean = red8(sm) * (1.f / 64.f); const float bonus = red8(sb);
            float sv = 0.f;
#pragma unroll
            for (int i = 0; i < 8; ++i) { y[i] -= mean; sv += y[i] * y[i]; }
            const float rs = rsqrtf(red8(sv) * (1.f / 64.f) + 64e-5f);
#pragma unroll
            for (int i = 0; i < 8; ++i) y[i] = (y[i] * rs * lw[i] + lb[i] + bonus * v[i]) * g[i];
            *(u32x4*)(yr + 512) = pack8(y);
        }
        if (hn) cur = nxt;
    }
}

__device__ __forceinline__ void glu_fixup_phase(int wv, const Params& p, bf16_t* ACT, const bf16_t* BND) {
    const int total = 256 * 2 * (DFF / 8);
    for (int idx = blockIdx.x * 512 + opaque_tid(wv); idx < total; idx += gridDim.x * 512) {
        const int blk = idx / (2 * (DFF / 8)), rem = idx % (2 * (DFF / 8)), tk = rem / (DFF / 8), c0 = (rem % (DFF / 8)) * 8;
        if (((blk * 128) % T) == 0) continue;
        const bf16_t* prev = BND + (size_t)(blk - 1) * 4 * LDGU + c0;
        const bf16_t* cur = BND + (size_t)(blk * 4 + 2) * LDGU + c0;
        float g126[8], g127[8], g0[8], g1[8], uu[8];
        unpack8(*(const u32x4*)prev, g126); unpack8(*(const u32x4*)(prev + LDGU), g127);
        unpack8(*(const u32x4*)cur, g0); unpack8(*(const u32x4*)(cur + LDGU), g1);
        unpack8(*(const u32x4*)(cur + tk * LDGU + DFF), uu);
        float o[8];
#pragma unroll
        for (int j = 0; j < 8; ++j) {
            const float x0 = tk ? g1[j] : g0[j], x1 = tk ? g0[j] : g127[j], x2 = tk ? g127[j] : g126[j];
            const float cv = p.conv_ffn[2 * DFF + c0 + j] * x0 + p.conv_ffn[DFF + c0 + j] * x1 + p.conv_ffn[c0 + j] * x2;
            o[j] = silu_(cv) * uu[j];
        }
        *(u32x4*)(ACT + (size_t)(blk * 128 + tk) * DFF + c0) = pack8(o);
    }
}

__global__ void __launch_bounds__(512, 2) fwd_megakernel(Params p) {
    extern __shared__ __attribute__((aligned(16))) unsigned char shm[];
    cg::grid_group grid = cg::this_grid();
    const int wv = __builtin_amdgcn_readfirstlane((int)threadIdx.x >> 6);
    LAS unsigned char* lds = (LAS unsigned char*)shm;
    bf16_t* wtin = (bf16_t*)(p.ws + WS_WTIN); bf16_t* wtbr = (bf16_t*)(p.ws + WS_WTBR); bf16_t* wtout = (bf16_t*)(p.ws + WS_WTOUT);
    bf16_t* wtf1 = (bf16_t*)(p.ws + WS_WTF1); bf16_t* wtf2 = (bf16_t*)(p.ws + WS_WTF2); bf16_t* wtlo = (bf16_t*)(p.ws + WS_WTLO);
    float* mod = (float*)(p.ws + WS_MOD); float* BA = (float*)(p.ws + WS_BA);
    bf16_t* H = (bf16_t*)(p.ws + WS_H); bf16_t* P = (bf16_t*)(p.ws + WS_P);
    bf16_t* LO = (bf16_t*)p.out; bf16_t* ALO = LO + (size_t)NTOK * LDLO;
    float* PEND = (float*)(p.ws + WS_PEND);
    bf16_t* X1 = (bf16_t*)p.out;
    bf16_t* X2 = H;
    bf16_t* Y = H; bf16_t* ACT = P; bf16_t* BND = (bf16_t*)(p.ws + WS_BND); bf16_t* HALO = (bf16_t*)(p.ws + WS_HALO);
    pg8::StaticOrder S;
    volatile LAS unsigned* xst = (volatile LAS unsigned*)(lds + LDS_STAGE);
    if (opaque_tid(wv) == 0) { xst[0] = 0u; xst[1] = 0u; xst[2] = 0u; xst[3] = 0u; }
    __syncthreads();
    XcdBarrier xb; xb.bar = (unsigned*)(p.ws + WS_BAR); xb.x = xb_xcc_id(); xb.st = xst;
    if (opaque_tid(wv) == 0) (void)xb_add(&xb.bar[XB_XCNT(xb.x)], 1u);

    phase0(wv, p, lds);
    xcd_barrier(wv, xb);
    if (xb_ld(&xb.bar[XB_TMO]) != 0u) grid.sync();
    norm_mod_phase(wv, p.x, p.norm1_w, mod, 1024, 0, H);
    xcd_barrier(wv, xb);
    { pg8::Gemm g{H, wtin, NTOK, 6144, 1024, 1024, 1024, 1 << 30, 0}; S.init(g.M, g.N, gridDim.x, blockIdx.x); EpiP E{P, BA, HALO}; pg8::gemm_phase(wv, lds, g, S, E); }
    xcd_barrier(wv, xb);
    lora_phase(wv, p, lds, P, wtlo, LO);
    xcd_barrier(wv, xb);
    prep2_phase(wv, p, P, BA, HALO, LO, PEND);
    xcd_barrier(wv, xb);
    scan_phase(wv, p, lds, P, BA, LO, PEND, Y);
    xcd_barrier(wv, xb);
    post_phase(wv, p, P, LO, Y);
    xcd_barrier(wv, xb);
    { pg8::Gemm g{Y, wtbr, NTOK, 2048, 512, 1024, 512, 4, 512}; pg8::PairOrder PO; PO.so.init(NTOK, 1024, gridDim.x, blockIdx.x); EpiBr E{P}; pg8::gemm_phase(wv, lds, g, PO, E); }
    xcd_barrier(wv, xb);
    { pg8::Gemm g{P, wtout, NTOK, 1024, 1024, LDP, 1024, 1 << 30, 0}; S.init(g.M, g.N, gridDim.x, blockIdx.x); EpiX1 E{p.x, X1, mod + 2048}; pg8::gemm_phase(wv, lds, g, S, E); }
    xcd_barrier(wv, xb);
    norm_mod_bf16_phase(wv, X1, p.norm2_w, mod, 4096, 3072, H);
    xcd_barrier(wv, xb);
    { pg8::Gemm g{H, wtf1, NTOK, 5632, 1024, 1024, 1024, 1 << 30, 0}; S.init(g.M, g.N, gridDim.x, blockIdx.x); EpiGLU E{ACT, BND, p.conv_ffn}; pg8::gemm_phase(wv, lds, g, S, E); }
    xcd_barrier(wv, xb);
    glu_fixup_phase(wv, p, ACT, BND);
    xcd_barrier(wv, xb);
    { pg8::Gemm g{ACT, wtf2, NTOK, 1024, 2816, DFF, 2816, 1 << 30, 0}; S.init(g.M, g.N, gridDim.x, blockIdx.x); EpiX2 E{X1, X2, mod + 5120}; pg8::gemm_phase(wv, lds, g, S, E); }
    xcd_barrier(wv, xb);
    final_norm_phase(wv, X2, p.out, p.norm_f_w);
}

extern "C" void kernel_launch(void* const* d_in, const int* in_sizes, int n_in, void* d_out, int out_size, void* d_ws, size_t ws_size, hipStream_t stream) {
    static int grid_blocks = 0;
    if (grid_blocks == 0) {
        if (n_in != 29 || out_size != NTOK * D || ws_size < WS_END) { fprintf(stderr, "kernel_launch: unexpected shapes (n_in %d out %d ws %zu need %zu)\n", n_in, out_size, ws_size, (size_t)WS_END); grid_blocks = -1; return; }
        int dev = 0, cus = 0, per_cu = 0;
        hipGetDevice(&dev);
        hipDeviceGetAttribute(&cus, hipDeviceAttributeMultiprocessorCount, dev);
        hipFuncSetAttribute((const void*)fwd_megakernel, hipFuncAttributeMaxDynamicSharedMemorySize, LDS_BYTES);
        hipOccupancyMaxActiveBlocksPerMultiprocessor(&per_cu, (const void*)fwd_megakernel, 512, LDS_BYTES);
        if (per_cu < 1) { fprintf(stderr, "kernel_launch: occupancy query says 0 blocks/CU\n"); per_cu = 1; }
        if (per_cu > 1) per_cu = 1;
        grid_blocks = cus * per_cu;
    }
    if (grid_blocks < 0) return;
    (void)hipMemsetAsync((char*)d_ws + WS_BAR, 0, (size_t)XCD_BAR_WORDS_C * 4, stream);
    Params p{};
    const float** fp = (const float**)&p;
    for (int i = 0; i < 29; ++i) fp[i] = (const float*)d_in[i];
    p.out = (float*)d_out; p.ws = (unsigned char*)d_ws;
    void* args[] = {&p};
    hipError_t e = hipLaunchCooperativeKernel((const void*)fwd_megakernel, dim3(grid_blocks), dim3(512), args, LDS_BYTES, stream);
    if (e != hipSuccess) fprintf(stderr, "cooperative launch failed: %s (grid %d)\n", hipGetErrorString(e), grid_blocks);
}
```
